# Optimizing an MI355X kernel written in HIP

```python
import jax, jax.numpy as jnp
from jax import lax
import numpy as np

D_MODEL = 1024
BATCH = 8
SEQ = 8192
DEPTH = 2

D_MIX = D_MODEL
RET_HEADS = 4
RET_QK_DIM = 64
RET_V_DIM = 128
RET_CHUNK = 256
RET_WIDTH = RET_HEADS * RET_V_DIM
POOL_GROUPS = 4
POOL_WINDOWS = (2, 4, 8, 16)
POOL_GROUP_DIM = 64
POOL_WIDTH = POOL_GROUPS * POOL_GROUP_DIM
MOBA_HEADS = 4
MOBA_HEAD_DIM = 64
MOBA_WIDTH = MOBA_HEADS * MOBA_HEAD_DIM
MOBA_BLOCK = 256
MOBA_TOPK = 3
MOBA_Q_BLOCK = 32
IN_COLS = 2 * RET_HEADS * RET_QK_DIM + 2 * RET_WIDTH + POOL_WIDTH + 3 * MOBA_WIDTH
D_FF = 2816
PLE_DIM = 256
EPS = 1e-6

kernel_name = "hybrid_retention_pool_moba_macaron_block"


def rmsnorm(x, g):
    xf = x.astype(jnp.float32)
    y = xf * lax.rsqrt(jnp.mean(xf * xf, axis=-1, keepdims=True) + EPS)
    return (y * g.astype(jnp.float32)).astype(x.dtype)


def swiglu(h, w_gate, w_up, w_down):
    return (jax.nn.silu(h @ w_gate) * (h @ w_up)) @ w_down


def pad_to_multiple(t, mult, axis):
    n = t.shape[axis]
    pad = (-n) % mult
    if pad == 0:
        return t
    widths = [(0, 0)] * t.ndim
    widths[axis] = (0, pad)
    return jnp.pad(t, widths)


def rotate_every_two(t):
    t1 = t[..., ::2]
    t2 = t[..., 1::2]
    return jnp.stack((-t2, t1), axis=-1).reshape(t.shape)


def retention(q, k, v, g):
    B, S, H, dk = q.shape
    dv = v.shape[-1]
    C = RET_CHUNK
    q = pad_to_multiple(q.astype(jnp.float32), C, 1)
    k = pad_to_multiple(k.astype(jnp.float32), C, 1)
    v = pad_to_multiple(v.astype(jnp.float32), C, 1)
    Sp = q.shape[1]
    NC = Sp // C
    pos = jnp.arange(Sp, dtype=jnp.float32)
    angle = 1.0 / (10000.0 ** jnp.linspace(0.0, 1.0, dk // 2, dtype=jnp.float32))
    angle = jnp.repeat(angle, 2)
    ang = pos[:, None] * angle[None, :]
    sin = jnp.sin(ang)[:, None, :]
    cos = jnp.cos(ang)[:, None, :]
    q = q * cos + rotate_every_two(q) * sin
    k = (k * cos + rotate_every_two(k) * sin) * (dk ** -0.5)
    log_gamma = jnp.log(1.0 - jnp.power(2.0, -5.0 - jnp.arange(H, dtype=jnp.float32)))
    idx = jnp.arange(C, dtype=jnp.float32)
    diff = idx[:, None] - idx[None, :]
    dmask = jnp.where(diff >= 0, jnp.exp(log_gamma[:, None, None] * jnp.maximum(diff, 0.0)), 0.0)
    xi = jnp.exp(log_gamma[:, None] * (idx + 1.0))[None, :, :, None]
    zeta = jnp.exp(log_gamma[:, None] * (C - 1.0 - idx))[None, :, :, None]
    gC = jnp.exp(log_gamma * C)[None, :, None, None]

    def to_chunks(t):
        return t.reshape(B, NC, C, H, t.shape[-1]).transpose(1, 0, 3, 2, 4)

    def step(R, inp):
        qj, kj, vj = inp
        inner = jnp.einsum('bhid,bhmd->bhim', qj, kj) * dmask
        out = (jnp.einsum('bhim,bhme->bhie', inner, vj)
               + jnp.einsum('bhid,bhde->bhie', qj, R) * xi)
        R = gC * R + jnp.einsum('bhmd,bhme->bhde', kj * zeta, vj)
        return R, out

    R0 = jnp.zeros((B, H, dk, dv), jnp.float32)
    _, o = lax.scan(step, R0, (to_chunks(q), to_chunks(k), to_chunks(v)))
    o = o.transpose(1, 0, 3, 2, 4).reshape(B, Sp, H, dv)[:, :S]
    mu = jnp.mean(o, axis=-1, keepdims=True)
    var = jnp.mean(jnp.square(o - mu), axis=-1, keepdims=True)
    o = (o - mu) * lax.rsqrt(var + EPS)
    o = o * jax.nn.silu(g.astype(jnp.float32))
    return o.reshape(B, S, H * dv)


def multiscale_pool(u, w, scale):
    B, S, _ = u.shape
    uf = u.astype(jnp.float32).reshape(B, S, POOL_GROUPS, POOL_GROUP_DIM)
    cs = jnp.concatenate([jnp.zeros((B, 1, POOL_GROUPS, POOL_GROUP_DIM), jnp.float32),
                          jnp.cumsum(uf, axis=1)], axis=1)
    t = jnp.arange(S)
    outs = []
    for gi, win in enumerate(POOL_WINDOWS):
        start = jnp.maximum(t + 1 - win, 0)
        cnt = (t + 1 - start).astype(jnp.float32)
        csg = cs[:, :, gi]
        wsum = csg[:, 1:] - csg[:, start]
        outs.append(wsum / cnt[None, :, None] - uf[:, :, gi])
    pooled = jnp.stack(outs, axis=2)
    y = jnp.einsum('bsgc,gcd->bsgd', pooled, w.astype(jnp.float32)).reshape(B, S, POOL_WIDTH)
    return y * scale.astype(jnp.float32)


def moba_attention(q, k, v):
    B, S, H, dh = q.shape
    BLK = MOBA_BLOCK
    QB = MOBA_Q_BLOCK
    q = pad_to_multiple(q.astype(jnp.float32).transpose(0, 2, 1, 3), BLK, 2) * (dh ** -0.5)
    k = pad_to_multiple(k.astype(jnp.float32).transpose(0, 2, 1, 3), BLK, 2)
    v = pad_to_multiple(v.astype(jnp.float32).transpose(0, 2, 1, 3), BLK, 2)
    Sp = q.shape[2]
    NB = Sp // BLK
    kb = k.reshape(B, H, NB, BLK, dh)
    vb = v.reshape(B, H, NB, BLK, dh)
    kmean = jnp.mean(kb, axis=3)
    gate = jnp.einsum('bhsd,bhnd->bhsn', q, kmean)
    qblk = jnp.arange(Sp) // BLK
    past = jnp.arange(NB)[None, :] < qblk[:, None]
    gate = jnp.where(past, gate, -jnp.inf)
    k_sel = min(MOBA_TOPK, NB)
    _, sel = lax.top_k(gate, k_sel)
    nqb = Sp // QB
    qs = q.reshape(B, H, nqb, QB, dh).transpose(2, 0, 1, 3, 4)
    sels = sel.reshape(B, H, nqb, QB, k_sel).transpose(2, 0, 1, 3, 4)
    bi = jnp.arange(B)[:, None, None, None]
    hi = jnp.arange(H)[None, :, None, None]

    def one_block(args):
        j, qj, selj = args
        q0 = j * QB
        own = q0 // BLK
        qpos = q0 + jnp.arange(QB)
        kpos = own * BLK + jnp.arange(BLK)
        k_own = lax.dynamic_index_in_dim(kb, own, axis=2, keepdims=False)
        v_own = lax.dynamic_index_in_dim(vb, own, axis=2, keepdims=False)
        k_g = kb[bi, hi, selj]
        v_g = vb[bi, hi, selj]
        s_own = jnp.einsum('bhqd,bhkd->bhqk', qj, k_own)
        s_own = jnp.where(kpos[None, :] <= qpos[:, None], s_own, -jnp.inf)
        s_sel = jnp.einsum('bhqd,bhqnkd->bhqnk', qj, k_g)
        valid = jnp.arange(k_sel) < own
        s_sel = jnp.where(valid[:, None], s_sel, -jnp.inf).reshape(B, H, QB, k_sel * BLK)
        probs = jax.nn.softmax(jnp.concatenate([s_sel, s_own], axis=-1), axis=-1)
        p_sel = probs[..., :k_sel * BLK].reshape(B, H, QB, k_sel, BLK)
        p_own = probs[..., k_sel * BLK:]
        return (jnp.einsum('bhqnk,bhqnkd->bhqd', p_sel, v_g)
                + jnp.einsum('bhqk,bhkd->bhqd', p_own, v_own))

    o = lax.map(one_block, (jnp.arange(nqb), qs, sels))
    o = o.transpose(1, 0, 3, 2, 4).reshape(B, Sp, H * dh)[:, :S]
    return o


def setup_inputs(seed: int = 0) -> dict:
    key = jax.random.key(seed)
    ks = jax.random.split(key, 20)
    f32 = jnp.float32

    def nrm(k, shape, scale):
        return jax.random.normal(k, shape, f32) * scale

    return {
        "x": nrm(ks[0], (BATCH, SEQ, D_MODEL), 1.0),
        "p": nrm(ks[1], (DEPTH, BATCH, SEQ, PLE_DIM), 1.0),
        "norm_ffn1": 1.0 + nrm(ks[2], (DEPTH, D_MODEL), 0.02),
        "ffn1_w_gate": nrm(ks[3], (DEPTH, D_MODEL, D_FF), D_MODEL ** -0.5),
        "ffn1_w_up": nrm(ks[4], (DEPTH, D_MODEL, D_FF), D_MODEL ** -0.5),
        "ffn1_w_down": nrm(ks[5], (DEPTH, D_FF, D_MODEL), D_FF ** -0.5),
        "norm_mix": 1.0 + nrm(ks[6], (DEPTH, D_MODEL), 0.02),
        "w_in": nrm(ks[7], (DEPTH, D_MODEL, IN_COLS), D_MODEL ** -0.5),
        "pool_w": nrm(ks[8], (DEPTH, POOL_GROUPS, POOL_GROUP_DIM, POOL_GROUP_DIM), POOL_GROUP_DIM ** -0.5),
        "pool_scale": 1.0 + nrm(ks[9], (DEPTH, POOL_WIDTH), 0.1),
        "w_out": nrm(ks[10], (DEPTH, D_MIX, D_MODEL), D_MIX ** -0.5),
        "norm_ffn2": 1.0 + nrm(ks[11], (DEPTH, D_MODEL), 0.02),
        "ffn2_w_gate": nrm(ks[12], (DEPTH, D_MODEL, D_FF), D_MODEL ** -0.5),
        "ffn2_w_up": nrm(ks[13], (DEPTH, D_MODEL, D_FF), D_MODEL ** -0.5),
        "ffn2_w_down": nrm(ks[14], (DEPTH, D_FF, D_MODEL), D_FF ** -0.5),
        "norm_ple": 1.0 + nrm(ks[15], (DEPTH, D_MODEL), 0.02),
        "ple_w_gate": nrm(ks[16], (DEPTH, D_MODEL, D_MODEL), D_MODEL ** -0.5),
        "ple_w_proj": nrm(ks[17], (DEPTH, PLE_DIM, D_MODEL), PLE_DIM ** -0.5),
        "norm_final": 1.0 + nrm(ks[18], (D_MODEL,), 0.02),
    }


def reference(x, p, norm_ffn1, ffn1_w_gate, ffn1_w_up, ffn1_w_down, norm_mix, w_in,
              pool_w, pool_scale, w_out, norm_ffn2, ffn2_w_gate, ffn2_w_up, ffn2_w_down,
              norm_ple, ple_w_gate, ple_w_proj, norm_final):
    B, S, _ = x.shape
    dqk = RET_HEADS * RET_QK_DIM
    offs = np.cumsum([dqk, dqk, RET_WIDTH, RET_WIDTH, POOL_WIDTH, MOBA_WIDTH, MOBA_WIDTH]).tolist()
    for i in range(DEPTH):
        h = rmsnorm(x, norm_ffn1[i])
        x = x + 0.5 * swiglu(h, ffn1_w_gate[i], ffn1_w_up[i], ffn1_w_down[i])
        h = rmsnorm(x, norm_mix[i])
        z = h @ w_in[i]
        rq, rk, rv, rg, pu, mq, mk, mv = jnp.split(z, offs, axis=-1)
        y_ret = retention(rq.reshape(B, S, RET_HEADS, RET_QK_DIM),
                          rk.reshape(B, S, RET_HEADS, RET_QK_DIM),
                          rv.reshape(B, S, RET_HEADS, RET_V_DIM),
                          rg.reshape(B, S, RET_HEADS, RET_V_DIM))
        y_pool = multiscale_pool(pu, pool_w[i], pool_scale[i])
        y_moba = moba_attention(mq.reshape(B, S, MOBA_HEADS, MOBA_HEAD_DIM),
                                mk.reshape(B, S, MOBA_HEADS, MOBA_HEAD_DIM),
                                mv.reshape(B, S, MOBA_HEADS, MOBA_HEAD_DIM))
        y = jnp.concatenate([y_ret, y_pool, y_moba], axis=-1).astype(x.dtype)
        x = x + y @ w_out[i]
        h = rmsnorm(x, norm_ffn2[i])
        x = x + 0.5 * swiglu(h, ffn2_w_gate[i], ffn2_w_up[i], ffn2_w_down[i])
        h = rmsnorm(x, norm_ple[i])
        x = x + jax.nn.sigmoid(h @ ple_w_gate[i]) * (p[i] @ ple_w_proj[i])
    return rmsnorm(x, norm_final)
```

```cpp
#include <hip/hip_runtime.h>
#include <hip/hip_cooperative_groups.h>
#include <cstdio>
#include <cstdint>
#include <cmath>
namespace cg = cooperative_groups;
namespace pg8 {
#define PG8_LAS __attribute__((address_space(3)))
typedef unsigned short bf16_t;
typedef short bf16x8 __attribute__((ext_vector_type(8)));
typedef float f32x4 __attribute__((ext_vector_type(4)));
typedef unsigned u32x4 __attribute__((ext_vector_type(4)));
constexpr int BM = 256, BK = 64, HALF = 128, HTB = HALF * BK * 2  , STAGE_BYTES = 8 * HTB, NXCD = 8, WGM = 8;

__host__ __device__ __forceinline__ int lds_byte(int r, int c) { const int st = (r >> 4) * 2 + (c >> 5), rr = r & 15, cc = c & 31, ob = rr * 64 + cc * 2; return st * 1024 + (ob ^ (((ob >> 9) & 1) << 5)); }
__host__ __device__ __forceinline__ void stage_rc(int b, int& R, int& C) { const int st = b / 1024, sb = b % 1024, swz = sb ^ (((sb >> 9) & 1) << 5); R = (st >> 1) * 16 + swz / 64; C = (st & 1) * 32 + (swz % 64) / 2; }
__host__ __device__ __forceinline__ int perm32(int rho) { const int n = rho >> 4, i = rho & 15; return 8 * (i >> 2) + 4 * n + (i & 3); }

struct Unit { int pm, pn; };
struct Gemm { const bf16_t* A; const bf16_t* Bt; int M, N, K; };

struct StaticOrder {
    int nM, nN, nwg, G, c;
    __host__ __device__ void init(int M, int N, int G_, int c_) { nM = M / BM; nN = N / BM; nwg = nM * nN; G = G_; c = c_; }
    __host__ __device__ bool next(int i, Unit& u) const {
        const long L = (long)i * G + c; if (L >= nwg) return false;
        int wgid = (int)L; { const int q = nwg / NXCD, r = nwg % NXCD, xcd = wgid % NXCD, off = wgid / NXCD; wgid = (xcd < r ? xcd * (q + 1) : r * (q + 1) + (xcd - r) * q) + off; }
        const int nig = WGM * nN, gid = wgid / nig, fm = gid * WGM, gsz = (nM - fm) < WGM ? (nM - fm) : WGM;
        u.pm = fm + ((wgid % nig) % gsz); u.pn = (wgid % nig) / gsz; return true;
    }
    __device__ __forceinline__ void a_ready(const Unit&) const {}
    __device__ __forceinline__ void done(const Unit&) const {}
};

__device__ __forceinline__ unsigned cvt_pk_bf16(float lo, float hi) { unsigned r; asm volatile("v_cvt_pk_bf16_f32 %0, %1, %2" : "=v"(r) : "v"(lo), "v"(hi)); return r; }
__device__ __forceinline__ float row_rstd(const float* ssp, int row, int fq) {
    const f32x4 v = *(const f32x4*)(ssp + (size_t)row * 16 + fq * 4);
    float s = (v[0] + v[1]) + (v[2] + v[3]);
    s += __shfl_xor(s, 16); s += __shfl_xor(s, 32);
    return 1.0f / sqrtf(s * (1.0f / 1024.0f) + 1e-6f);
}
__device__ __forceinline__ float silu_f(float g) { return g * __builtin_amdgcn_rcpf(1.0f + __builtin_amdgcn_exp2f(-1.44269504089f * g)); }
__device__ __forceinline__ float sigm_f(float g) { return __builtin_amdgcn_rcpf(1.0f + __builtin_amdgcn_exp2f(-1.44269504089f * g)); }

struct EpiGLU {
    static constexpr bool PERM = true, AFTER_DRAIN = false;
    bf16_t* H; int ldh; const float* ssp;
    __device__ __forceinline__ void operator()(const f32x4 (&acc)[2][2][4][2], const Unit& u, int wr, int wc, int fr, int fq) const {
        const int row0 = u.pm * BM + wr * 64 + fr, col0 = u.pn * HALF + wc * 32 + 8 * fq;
#pragma unroll
        for (int ai = 0; ai < 2; ++ai)
#pragma unroll
            for (int m = 0; m < 4; ++m) {
                const int row = row0 + ai * HALF + m * 16; const float r = row_rstd(ssp, row, fq);
                const f32x4 g0 = acc[ai][0][m][0] * r, g1 = acc[ai][0][m][1] * r, u0 = acc[ai][1][m][0] * r, u1 = acc[ai][1][m][1] * r;
                u32x4 w;
                w.x = cvt_pk_bf16(silu_f(g0[0]) * u0[0], silu_f(g0[1]) * u0[1]); w.y = cvt_pk_bf16(silu_f(g0[2]) * u0[2], silu_f(g0[3]) * u0[3]);
                w.z = cvt_pk_bf16(silu_f(g1[0]) * u1[0], silu_f(g1[1]) * u1[1]); w.w = cvt_pk_bf16(silu_f(g1[2]) * u1[2], silu_f(g1[3]) * u1[3]);
                *(u32x4*)(H + (size_t)row * ldh + col0) = w;
            }
    }
};
__device__ __forceinline__ void unpack8(const u32x4 w, f32x4& a, f32x4& b) {
    a[0] = __uint_as_float(w.x << 16); a[1] = __uint_as_float(w.x & 0xffff0000u); a[2] = __uint_as_float(w.y << 16); a[3] = __uint_as_float(w.y & 0xffff0000u);
    b[0] = __uint_as_float(w.z << 16); b[1] = __uint_as_float(w.z & 0xffff0000u); b[2] = __uint_as_float(w.w << 16); b[3] = __uint_as_float(w.w & 0xffff0000u);
}
template <int MODE> struct EpiRes {
    static constexpr bool PERM = true, AFTER_DRAIN = false;
    const bf16_t* xin; bf16_t* xout; float* ssp_out; float alpha; const float* ssp_in; const bf16_t* PP;
    __device__ __forceinline__ void operator()(const f32x4 (&acc)[2][2][4][2], const Unit& u, int wr, int wc, int fr, int fq) const {
        const int row0 = u.pm * BM + wr * 64 + fr, col0 = u.pn * BM + wc * 32 + 8 * fq;
        constexpr int MB = (MODE == 1) ? 2 : 4;
#pragma unroll
        for (int ai = 0; ai < 2; ++ai)
#pragma unroll
        for (int mb = 0; mb < 4; mb += MB) {
            u32x4 xv[MB][2], pv[MB][2]; float r[MB];
#pragma unroll
            for (int mm = 0; mm < MB; ++mm) {
                const int m = mb + mm; const size_t off = (size_t)(row0 + ai * HALF + m * 16) * 1024 + col0;
                xv[mm][0] = *(const u32x4*)(xin + off); xv[mm][1] = *(const u32x4*)(xin + off + HALF);
                if (MODE == 1) { pv[mm][0] = *(const u32x4*)(PP + off); pv[mm][1] = *(const u32x4*)(PP + off + HALF); r[mm] = row_rstd(ssp_in, row0 + ai * HALF + m * 16, fq); }
            }
#pragma unroll
            for (int mm = 0; mm < MB; ++mm) {
                const int m = mb + mm; const int row = row0 + ai * HALF + m * 16; float ss = 0.f;
#pragma unroll
                for (int bj = 0; bj < 2; ++bj) {
                    f32x4 a, b, d0, d1; unpack8(xv[mm][bj], a, b);
                    if (MODE == 0) { d0 = acc[ai][bj][m][0] * alpha; d1 = acc[ai][bj][m][1] * alpha; }
                    else {
                        f32x4 p0, p1; unpack8(pv[mm][bj], p0, p1);
                        const f32x4 t0 = acc[ai][bj][m][0] * r[mm], t1 = acc[ai][bj][m][1] * r[mm];
#pragma unroll
                        for (int k = 0; k < 4; ++k) { d0[k] = sigm_f(t0[k]) * p0[k]; d1[k] = sigm_f(t1[k]) * p1[k]; }
                    }
                    a = a + d0; b = b + d1;
                    u32x4 w; w.x = cvt_pk_bf16(a[0], a[1]); w.y = cvt_pk_bf16(a[2], a[3]); w.z = cvt_pk_bf16(b[0], b[1]); w.w = cvt_pk_bf16(b[2], b[3]);
                    *(u32x4*)(xout + (size_t)row * 1024 + col0 + bj * HALF) = w;
                    unpack8(w, a, b);
                    ss += ((a[0] * a[0] + a[1] * a[1]) + (a[2] * a[2] + a[3] * a[3])) + ((b[0] * b[0] + b[1] * b[1]) + (b[2] * b[2] + b[3] * b[3]));
                }
                ss += __shfl_xor(ss, 16); ss += __shfl_xor(ss, 32);
                if (fq == 0) ssp_out[(size_t)row * 16 + u.pn * 4 + wc] = ss;
            }
        }
    }
};
struct EpiZ {
    static constexpr bool PERM = true, AFTER_DRAIN = false;
    bf16_t* Z; const float* ssp; const float* cs;
    __device__ __forceinline__ void operator()(const f32x4 (&acc)[2][2][4][2], const Unit& u, int wr, int wc, int fr, int fq) const {
        const int row0 = u.pm * BM + wr * 64 + fr, col0 = u.pn * BM + wc * 32 + 8 * fq;
        const bool rot = u.pn < 2; const float sc = (u.pn == 1 || u.pn == 7) ? 0.125f : 1.0f;
#pragma unroll
        for (int ai = 0; ai < 2; ++ai)
#pragma unroll
            for (int m = 0; m < 4; ++m) {
                const int row = row0 + ai * HALF + m * 16; const float r = row_rstd(ssp, row, fq) * sc;
#pragma unroll
                for (int bj = 0; bj < 2; ++bj) {
                    const int col = col0 + bj * HALF;
                    f32x4 a = acc[ai][bj][m][0] * r, b = acc[ai][bj][m][1] * r;
                    if (rot) {
                        const float* t = cs + ((size_t)(row & 8191) * 32 + ((col & 63) >> 1)) * 2;
                        const f32x4 t0 = *(const f32x4*)t, t1 = *(const f32x4*)(t + 4);
                        f32x4 a2, b2;
                        a2[0] = a[0] * t0[0] - a[1] * t0[1]; a2[1] = a[1] * t0[0] + a[0] * t0[1];
                        a2[2] = a[2] * t0[2] - a[3] * t0[3]; a2[3] = a[3] * t0[2] + a[2] * t0[3];
                        b2[0] = b[0] * t1[0] - b[1] * t1[1]; b2[1] = b[1] * t1[0] + b[0] * t1[1];
                        b2[2] = b[2] * t1[2] - b[3] * t1[3]; b2[3] = b[3] * t1[2] + b[2] * t1[3];
                        a = a2; b = b2;
                    }
                    u32x4 w; w.x = cvt_pk_bf16(a[0], a[1]); w.y = cvt_pk_bf16(a[2], a[3]); w.z = cvt_pk_bf16(b[0], b[1]); w.w = cvt_pk_bf16(b[2], b[3]);
                    *(u32x4*)(Z + (size_t)row * 2560 + col) = w;
                }
            }
    }
};
struct EpiPlain {
    static constexpr bool PERM = true, AFTER_DRAIN = false;
    bf16_t* O; int ldc;
    __device__ __forceinline__ void operator()(const f32x4 (&acc)[2][2][4][2], const Unit& u, int wr, int wc, int fr, int fq) const {
        const int row0 = u.pm * BM + wr * 64 + fr, col0 = u.pn * BM + wc * 32 + 8 * fq;
#pragma unroll
        for (int ai = 0; ai < 2; ++ai)
#pragma unroll
            for (int m = 0; m < 4; ++m)
#pragma unroll
                for (int bj = 0; bj < 2; ++bj) {
                    const f32x4 a = acc[ai][bj][m][0], b = acc[ai][bj][m][1];
                    u32x4 w; w.x = cvt_pk_bf16(a[0], a[1]); w.y = cvt_pk_bf16(a[2], a[3]); w.z = cvt_pk_bf16(b[0], b[1]); w.w = cvt_pk_bf16(b[2], b[3]);
                    *(u32x4*)(O + (size_t)(row0 + ai * HALF + m * 16) * ldc + col0 + bj * HALF) = w;
                }
    }
};

template <class Epi, class Sched, bool ALIGN_EPI = false, bool SP2 = false>
__device__ __forceinline__ void gemm_phase(PG8_LAS unsigned char* lds, const Gemm g, const Sched& S, const Epi& E) {
    int tid_l = threadIdx.x; asm volatile("" : "+v"(tid_l));
    const int tid = tid_l, wid = __builtin_amdgcn_readfirstlane(tid >> 6), lane = tid & 63, wr = wid >> 2, wc = wid & 3, fr = lane & 15, fq = lane >> 4;
    const int K = g.K, nt = K / BK;
    unsigned voffA[2], voffB[2];
#pragma unroll
    for (int i = 0; i < 2; ++i) { int R, C; stage_rc(tid * 16 + i * 8192, R, C); const int Rb = Epi::PERM ? ((R & ~31) + perm32(R & 31)) : R;
        voffA[i] = (unsigned)(R * K + C) * 2u; voffB[i] = (unsigned)(Rb * K + C) * 2u; }
    const size_t kstep = (size_t)(BK * 2);
    const size_t hstep = (size_t)HALF * K * 2;
    const size_t tstep = 2 * hstep;
    const unsigned ldsw = (unsigned)wid * 1024u;
    const int aoff = lds_byte(wr * 64 + fr, fq * 8), boff = lds_byte(wc * 32 + fr, fq * 8);
#define PG8_SA(b, h) (((b) * 2 + (h)) * HTB)
#define PG8_SB(b, h) ((4 + (b) * 2 + (h)) * HTB)
#define PG8_STAGE(bufoff, gbase, voff) do { _Pragma("unroll") for (int _i = 0; _i < 2; ++_i) \
        __builtin_amdgcn_global_load_lds((const unsigned*)((const char*)(gbase) + (voff)[_i]), (PG8_LAS unsigned*)(lds + (bufoff) + ldsw + _i * 8192), 16, 0, 0); } while (0)
#define PG8_LDA(dst, b, h) do { _Pragma("unroll") for (int m = 0; m < 4; ++m) _Pragma("unroll") for (int k = 0; k < 2; ++k) dst[m][k] = *(const PG8_LAS bf16x8*)(lds + PG8_SA(b, h) + aoff + m * 2048 + k * 1024); } while (0)
#define PG8_LDB(dst, b, h) do { _Pragma("unroll") for (int n = 0; n < 2; ++n) _Pragma("unroll") for (int k = 0; k < 2; ++k) dst[n][k] = *(const PG8_LAS bf16x8*)(lds + PG8_SB(b, h) + boff + n * 2048 + k * 1024); } while (0)
#define PG8_MMA(ai, bj, At, Bt) do { __builtin_amdgcn_s_setprio(1); _Pragma("unroll") for (int m = 0; m < 4; ++m) _Pragma("unroll") for (int n = 0; n < 2; ++n) _Pragma("unroll") for (int k = 0; k < 2; ++k) \
        acc[ai][bj][m][n] = __builtin_amdgcn_mfma_f32_16x16x32_bf16(Bt[n][k], At[m][k], acc[ai][bj][m][n], 0, 0, 0); __builtin_amdgcn_s_setprio(0); } while (0)
#define PG8_WAIT_V(n) asm volatile("s_waitcnt vmcnt(" #n ")" ::: "memory")
#define PG8_WAIT_L(n) asm volatile("s_waitcnt lgkmcnt(" #n ")" ::: "memory")
#define PG8_BAR __builtin_amdgcn_s_barrier()
#define PG8_SCHED __builtin_amdgcn_sched_barrier(0)
    Unit cur, nxt; int ui = 0;
    if (!S.next(0, cur)) return;
    f32x4 acc[2][2][4][2];
#pragma unroll
    for (int a = 0; a < 2; ++a)
#pragma unroll
        for (int b = 0; b < 2; ++b)
#pragma unroll
            for (int m = 0; m < 4; ++m)
#pragma unroll
                for (int n = 0; n < 2; ++n) acc[a][b][m][n] = (f32x4){0.f, 0.f, 0.f, 0.f};
    bf16x8 At[4][2], B0[2][2], B1[2][2];
    const char* cA = (const char*)g.A + (size_t)cur.pm * tstep; const char* cB = (const char*)g.Bt + (size_t)cur.pn * tstep;
    S.a_ready(cur);
    if constexpr (SP2) {
        PG8_STAGE(PG8_SB(0, 0), cB, voffB); PG8_STAGE(PG8_SB(0, 1), cB + hstep, voffB); PG8_STAGE(PG8_SA(0, 0), cA, voffA); PG8_STAGE(PG8_SA(0, 1), cA + hstep, voffA);
        if (wr == 1) PG8_BAR;
        PG8_WAIT_V(2); PG8_BAR;
        PG8_STAGE(PG8_SB(1, 0), cB + kstep, voffB); PG8_STAGE(PG8_SA(1, 0), cA + kstep, voffA); PG8_STAGE(PG8_SB(1, 1), cB + hstep + kstep, voffB);
        PG8_WAIT_V(6); PG8_BAR;
    } else {
        PG8_STAGE(PG8_SB(0, 0), cB, voffB); PG8_STAGE(PG8_SA(0, 0), cA, voffA); PG8_STAGE(PG8_SB(0, 1), cB + hstep, voffB); PG8_STAGE(PG8_SA(0, 1), cA + hstep, voffA);
        if (wr == 1) PG8_BAR;
        PG8_WAIT_V(4); PG8_BAR;
        PG8_STAGE(PG8_SB(1, 0), cB + kstep, voffB); PG8_STAGE(PG8_SA(1, 0), cA + kstep, voffA); PG8_STAGE(PG8_SB(1, 1), cB + hstep + kstep, voffB);
        PG8_WAIT_V(6); PG8_BAR;
    }
    for (;;) {
        const bool has_next = S.next(ui + 1, nxt);
        const char* nA = has_next ? (const char*)g.A + (size_t)nxt.pm * tstep : cA; const char* nB = has_next ? (const char*)g.Bt + (size_t)nxt.pn * tstep : cB;
#pragma unroll 1
        for (int t = 0; t < nt; t += 2) {
            const bool last = (t == nt - 2);
            const char* a1 = cA + (size_t)(t + 1) * kstep;
            const char* a2 = last ? nA : cA + (size_t)(t + 2) * kstep; const char* b2 = last ? nB : cB + (size_t)(t + 2) * kstep;
            const char* a3 = a2 + kstep; const char* b3 = b2 + kstep;
            if (last && has_next) S.a_ready(nxt);
            if constexpr (SP2) {
            PG8_LDB(B0, 0, 0); PG8_LDB(B1, 0, 1); PG8_SCHED; PG8_LDA(At, 0, 0); PG8_STAGE(PG8_SA(1, 1), a1 + hstep, voffA);
            PG8_WAIT_V(8); PG8_WAIT_L(0); PG8_BAR; PG8_MMA(0, 0, At, B0); PG8_MMA(0, 1, At, B1); PG8_BAR; PG8_SCHED;
            PG8_LDA(At, 0, 1); PG8_STAGE(PG8_SB(0, 0), b2, voffB); PG8_STAGE(PG8_SB(0, 1), b2 + hstep, voffB); PG8_STAGE(PG8_SA(0, 0), a2, voffA);
            PG8_WAIT_V(8); PG8_WAIT_L(0); PG8_BAR; PG8_MMA(1, 0, At, B0); PG8_MMA(1, 1, At, B1); PG8_BAR; PG8_SCHED;
            PG8_LDB(B0, 1, 0); PG8_LDB(B1, 1, 1); PG8_SCHED; PG8_LDA(At, 1, 0); PG8_STAGE(PG8_SA(0, 1), a2 + hstep, voffA);
            PG8_WAIT_V(8); PG8_WAIT_L(0); PG8_BAR; PG8_MMA(0, 0, At, B0); PG8_MMA(0, 1, At, B1); PG8_BAR; PG8_SCHED;
            PG8_LDA(At, 1, 1); PG8_STAGE(PG8_SB(1, 0), b3, voffB); PG8_STAGE(PG8_SB(1, 1), b3 + hstep, voffB); PG8_STAGE(PG8_SA(1, 0), a3, voffA);
            PG8_WAIT_V(8); PG8_WAIT_L(0); PG8_BAR; PG8_MMA(1, 0, At, B0); PG8_MMA(1, 1, At, B1); PG8_BAR; PG8_SCHED;
            } else {
            PG8_LDB(B0, 0, 0); PG8_SCHED; PG8_LDA(At, 0, 0); PG8_STAGE(PG8_SA(1, 1), a1 + hstep, voffA);
            PG8_WAIT_L(8); PG8_BAR; PG8_WAIT_L(0); PG8_MMA(0, 0, At, B0); PG8_BAR; PG8_SCHED;
            PG8_LDB(B1, 0, 1); PG8_STAGE(PG8_SB(0, 0), b2, voffB);
            PG8_BAR; PG8_WAIT_L(0); PG8_MMA(0, 1, At, B1); PG8_BAR;
            PG8_LDA(At, 0, 1); PG8_STAGE(PG8_SA(0, 0), a2, voffA);
            PG8_BAR; PG8_WAIT_L(0); PG8_MMA(1, 0, At, B0); PG8_BAR; PG8_SCHED;
            PG8_STAGE(PG8_SB(0, 1), b2 + hstep, voffB);
            PG8_WAIT_V(6); PG8_BAR; PG8_MMA(1, 1, At, B1); PG8_BAR;
            PG8_LDB(B0, 1, 0); PG8_SCHED; PG8_LDA(At, 1, 0); PG8_STAGE(PG8_SA(0, 1), a2 + hstep, voffA);
            PG8_WAIT_L(8); PG8_BAR; PG8_WAIT_L(0); PG8_MMA(0, 0, At, B0); PG8_BAR; PG8_SCHED;
            PG8_LDB(B1, 1, 1); PG8_STAGE(PG8_SB(1, 0), b3, voffB);
            PG8_BAR; PG8_WAIT_L(0); PG8_MMA(0, 1, At, B1); PG8_BAR;
            PG8_LDA(At, 1, 1); PG8_STAGE(PG8_SA(1, 0), a3, voffA);
            PG8_BAR; PG8_WAIT_L(0); PG8_MMA(1, 0, At, B0); PG8_BAR; PG8_SCHED;
            PG8_STAGE(PG8_SB(1, 1), b3 + hstep, voffB);
            PG8_WAIT_V(6); PG8_BAR; PG8_MMA(1, 1, At, B1); PG8_BAR;
            }
        }
        if constexpr (ALIGN_EPI) { if (wr == 0) PG8_BAR; }
        if constexpr (!Epi::AFTER_DRAIN) { E(acc, cur, wr, wc, fr, fq); S.done(cur); }
        if (!has_next) break;
#pragma unroll
        for (int a = 0; a < 2; ++a)
#pragma unroll
            for (int b = 0; b < 2; ++b)
#pragma unroll
                for (int m = 0; m < 4; ++m)
#pragma unroll
                    for (int n = 0; n < 2; ++n) acc[a][b][m][n] = (f32x4){0.f, 0.f, 0.f, 0.f};
        cur = nxt; cA = nA; cB = nB; ++ui;
        if constexpr (ALIGN_EPI) { if (wr == 1) PG8_BAR; }
    }
    PG8_WAIT_V(0);
    if constexpr (!ALIGN_EPI) { if (wr == 0) PG8_BAR; }
    PG8_BAR;
    if constexpr (Epi::AFTER_DRAIN) { E.fused(acc, cur, wr, wc, fr, fq, lds, wid, lane); S.done(cur); }
#undef PG8_SA
#undef PG8_SB
#undef PG8_STAGE
#undef PG8_LDA
#undef PG8_LDB
#undef PG8_MMA
#undef PG8_WAIT_V
#undef PG8_WAIT_L
#undef PG8_BAR
#undef PG8_SCHED
}
}

#define LAS __attribute__((address_space(3)))
typedef unsigned short bf16;
typedef float f32x4 __attribute__((ext_vector_type(4)));
typedef unsigned u32x4 __attribute__((ext_vector_type(4)));
typedef unsigned u32x2 __attribute__((ext_vector_type(2)));

constexpr int NWAVES = 8, NTHR = 512;
constexpr int BATCH = 8, SEQ = 8192, D = 1024, FF = 2816, INC = 2560, PLE = 256, DEPTH = 2;
constexpr int M = BATCH * SEQ;
constexpr int ZQ = 0, ZK = 256, ZV = 512, ZG = 1024, ZP = 1536, ZMQ = 1792, ZMK = 2048, ZMV = 2304;
constexpr size_t MiB = 1u << 20;
constexpr size_t WS_CS = 1 * MiB, WS_SS0 = 3 * MiB, WS_SS1 = 7 * MiB, WS_KMEAN = 11 * MiB, WS_W = 12 * MiB;
constexpr size_t W_GU1 = 0, W_D1 = W_GU1 + (size_t)2 * FF * D, W_IN = W_D1 + (size_t)D * FF, W_OUT = W_IN + (size_t)INC * D, W_GU2 = W_OUT + (size_t)D * D,
                 W_D2 = W_GU2 + (size_t)2 * FF * D, W_PG = W_D2 + (size_t)D * FF, W_PP = W_PG + (size_t)D * D, W_LAYER = W_PP + (size_t)D * PLE;
static_assert(WS_W + 2 * W_LAYER * 2 <= 100 * MiB, "weights");
constexpr size_t WS_XB = 100 * MiB, WS_HZ = 228 * MiB, WS_Y = 580 * MiB, WS_PB = 708 * MiB, WS_KV = 772 * MiB, WS_RS = 804 * MiB, WS_XB2 = 836 * MiB, WS_END = 964 * MiB;
static_assert((size_t)M * FF * 2 == 352 * MiB && (size_t)M * D * 2 == 128 * MiB, "sizes");
constexpr int LDS_BYTES = 147456;

__device__ __forceinline__ unsigned f2bf(float f) { unsigned u = __builtin_bit_cast(unsigned, f); return (u + 0x7fffu + ((u >> 16) & 1u)) >> 16; }
__device__ __forceinline__ unsigned pk2(float lo, float hi) { return pg8::cvt_pk_bf16(lo, hi); }
__device__ __forceinline__ float bflo(unsigned w) { return __uint_as_float(w << 16); }
__device__ __forceinline__ float bfhi(unsigned w) { return __uint_as_float(w & 0xffff0000u); }
__device__ __forceinline__ float bf1(bf16 h) { return __uint_as_float((unsigned)h << 16); }
__device__ __forceinline__ float wave_sum(float v) {
#pragma unroll
    for (int o = 1; o < 64; o <<= 1) v += __shfl_xor(v, o);
    return v;
}
#define LDS_WAIT() asm volatile("s_waitcnt lgkmcnt(0)" ::: "memory")

struct Args {
    const float* in[19]; float* out; unsigned char* ws;
    double theta[32]; float lg2g[4];
    int ph_lo, ph_hi;
};

__device__ __forceinline__ void transpose_item(const float* W, int K, int N, const float* gain, bf16* WT, int k0, int n0, int row_off, LAS float* scr, int lane) {
#pragma unroll 8
    for (int i = 0; i < 32; ++i) { const int kk = 2 * i + (lane >> 5); float v = W[(size_t)(k0 + kk) * N + n0 + (lane & 31)]; if (gain) v *= gain[k0 + kk]; scr[kk * 33 + (lane & 31)] = v; }
    LDS_WAIT(); asm volatile("" ::: "memory");
    const int c = lane & 7;
#pragma unroll
    for (int j = 0; j < 4; ++j) { const int n = (lane >> 3) + 8 * j; const LAS float* s = scr + (8 * c) * 33 + n;
        u32x4 o; o.x = pk2(s[0 * 33], s[1 * 33]); o.y = pk2(s[2 * 33], s[3 * 33]); o.z = pk2(s[4 * 33], s[5 * 33]); o.w = pk2(s[6 * 33], s[7 * 33]);
        *(u32x4*)(WT + (size_t)(row_off + n) * K + k0 + 8 * c) = o; }
    LDS_WAIT(); asm volatile("" ::: "memory");
}
__device__ __forceinline__ void tr_plain(const float* W, int K, int N, const float* gain, bf16* WT, int it, LAS float* scr, int lane) {
    const int nblk = N / 32, kb = it / nblk, nb = it % nblk; transpose_item(W, K, N, gain, WT, 64 * kb, 32 * nb, 32 * nb, scr, lane);
}
__device__ __forceinline__ void tr_glu(const float* W, const float* gain, bf16* WT, int up, int it, LAS float* scr, int lane) {
    const int nblk = FF / 32, kb = it / nblk, nb = it % nblk, n0 = 32 * nb; transpose_item(W, D, FF, gain, WT, 64 * kb, n0, (n0 >> 7) * 256 + (n0 & 127) + up * 128, scr, lane);
}

__device__ __forceinline__ void sincos_d(double x, float& c, float& s) {
    const double TWO_PI = 6.283185307179586476925286766559;
    const double n = rint(x / TWO_PI); const double r = x - n * TWO_PI, r2 = r * r;
    double ss = 1.0, cc = 1.0;
#pragma unroll
    for (int k = 15; k >= 1; --k) { ss = 1.0 - r2 * (1.0 / (double)((2 * k) * (2 * k + 1))) * ss; cc = 1.0 - r2 * (1.0 / (double)((2 * k - 1) * (2 * k))) * cc; }
    s = (float)(r * ss); c = (float)cc;
}

__device__ __forceinline__ void phase_prologue(const Args& a, LAS unsigned char* lds, int tid, int lane, int wave, int G) {
    unsigned char* ws = a.ws;
    LAS float* scr = (LAS float*)(lds + wave * 16384);
    const int gw = blockIdx.x * NWAVES + wave, NGW = G * NWAVES;
    constexpr int I_GU = (D / 64) * (FF / 32), I_DN = (FF / 64) * (D / 32), I_IN = (D / 64) * (INC / 32), I_SQ = (D / 64) * (D / 32), I_PP = (PLE / 64) * (D / 32);
    constexpr int I_LAYER = 4 * I_GU + 2 * I_DN + I_IN + 2 * I_SQ + I_PP;
    for (int it = gw; it < DEPTH * I_LAYER; it += NGW) {
        const int L = it / I_LAYER; int r = it % I_LAYER;
        bf16* wl = (bf16*)(ws + WS_W) + (size_t)L * W_LAYER;
        const float* n1 = a.in[2] + L * D; const float* nm = a.in[6] + L * D; const float* n2 = a.in[11] + L * D; const float* np = a.in[15] + L * D;
        if (r < I_GU) { tr_glu(a.in[3] + (size_t)L * D * FF, n1, wl + W_GU1, 0, r, scr, lane); continue; } r -= I_GU;
        if (r < I_GU) { tr_glu(a.in[4] + (size_t)L * D * FF, n1, wl + W_GU1, 1, r, scr, lane); continue; } r -= I_GU;
        if (r < I_DN) { tr_plain(a.in[5] + (size_t)L * FF * D, FF, D, nullptr, wl + W_D1, r, scr, lane); continue; } r -= I_DN;
        if (r < I_IN) { tr_plain(a.in[7] + (size_t)L * D * INC, D, INC, nm, wl + W_IN, r, scr, lane); continue; } r -= I_IN;
        if (r < I_SQ) { tr_plain(a.in[10] + (size_t)L * D * D, D, D, nullptr, wl + W_OUT, r, scr, lane); continue; } r -= I_SQ;
        if (r < I_GU) { tr_glu(a.in[12] + (size_t)L * D * FF, n2, wl + W_GU2, 0, r, scr, lane); continue; } r -= I_GU;
        if (r < I_GU) { tr_glu(a.in[13] + (size_t)L * D * FF, n2, wl + W_GU2, 1, r, scr, lane); continue; } r -= I_GU;
        if (r < I_DN) { tr_plain(a.in[14] + (size_t)L * FF * D, FF, D, nullptr, wl + W_D2, r, scr, lane); continue; } r -= I_DN;
        if (r < I_SQ) { tr_plain(a.in[16] + (size_t)L * D * D, D, D, np, wl + W_PG, r, scr, lane); continue; } r -= I_SQ;
        tr_plain(a.in[17] + (size_t)L * PLE * D, PLE, D, nullptr, wl + W_PP, r, scr, lane);
    }
    {
        const float* x = a.in[0]; bf16* xb = (bf16*)(ws + WS_XB2); float* ss = (float*)(ws + WS_SS0);
        for (int m = gw; m < M; m += NGW) {
            const f32x4* xr = (const f32x4*)(x + (size_t)m * D) + lane; u32x2* brow = (u32x2*)(xb + (size_t)m * D) + lane;
            float s = 0.f;
#pragma unroll
            for (int j = 0; j < 4; ++j) { const f32x4 v = xr[64 * j]; u32x2 w; w.x = pk2(v[0], v[1]); w.y = pk2(v[2], v[3]); brow[64 * j] = w;
                const float r0 = bflo(w.x), r1 = bfhi(w.x), r2 = bflo(w.y), r3 = bfhi(w.y); s += (r0 * r0 + r1 * r1) + (r2 * r2 + r3 * r3); }
            s = wave_sum(s);
            if (lane < 16) ss[(size_t)m * 16 + lane] = (lane == 0) ? s : 0.f;
        }
    }
    {
        const f32x4* p = (const f32x4*)a.in[1]; u32x2* pb = (u32x2*)(ws + WS_PB);
        const size_t n4 = (size_t)DEPTH * M * PLE / 4;
        for (size_t i = (size_t)blockIdx.x * NTHR + tid; i < n4; i += (size_t)G * NTHR) { const f32x4 v = p[i]; u32x2 w; w.x = pk2(v[0], v[1]); w.y = pk2(v[2], v[3]); pb[i] = w; }
    }
    {
        float* cs = (float*)(ws + WS_CS);
        for (int i = blockIdx.x * NTHR + tid; i < SEQ * 32; i += G * NTHR) { const int pos = i >> 5, k = i & 31; float c, s; sincos_d((double)pos * a.theta[k], c, s); cs[2 * i] = c; cs[2 * i + 1] = s; }
    }
}


typedef float f32x16 __attribute__((ext_vector_type(16)));
typedef short bf16x8 __attribute__((ext_vector_type(8)));
#define MFMA32(a, b, c) __builtin_amdgcn_mfma_f32_32x32x16_bf16((a), (b), (c), 0, 0, 0)
constexpr size_t OUT_VTM = 0, OUT_VTR = 32 * MiB, OUT_KTZ = 96 * MiB;
__device__ __forceinline__ int crow(int i, int hh) { return (i & 3) + 8 * (i >> 2) + 4 * hh; }

__device__ __forceinline__ void prep_transposes(const Args& a, LAS unsigned char* lds, int tid, int G, unsigned char* ws_, unsigned char* outb_) {
    unsigned char* ws = ws_; unsigned char* outb = outb_; (void)outb; const bf16* Z = (const bf16*)(ws + WS_HZ);
    LAS unsigned* T = (LAS unsigned*)lds;
    const int lane = tid & 63, w = tid >> 6;
    for (int it = blockIdx.x; it < BATCH * 32 * 5; it += G) {
        const int kind = it % 5, blk = (it / 5) & 31, b = it / 160;
        const int src = kind == 0 ? ZMV : (kind == 1 ? ZV : (kind == 2 ? ZV + 256 : (kind == 3 ? ZK : ZMK)));
        bf16* dst = kind == 0 ? (bf16*)(outb + OUT_VTM) + (size_t)b * 256 * SEQ : (kind == 3 ? (bf16*)(outb + OUT_KTZ) + (size_t)b * 256 * SEQ : (bf16*)(outb + OUT_VTR) + ((size_t)b * 512 + (kind == 2 ? 256 : 0)) * SEQ);
        __syncthreads();
        for (int c = tid; c < 256 * 32; c += NTHR) { const int r = c >> 5, cc = c & 31; const u32x4 v = *(const u32x4*)(Z + ((size_t)b * SEQ + blk * 256 + r) * INC + src + cc * 8);
            LAS unsigned* t = T + r * 129 + cc * 4; t[0] = v.x; t[1] = v.y; t[2] = v.z; t[3] = v.w; }
        __syncthreads();
        if (kind == 4) {
            if (tid < 256) { const LAS bf16* tp = (const LAS bf16*)T + tid; float s = 0.f;
#pragma unroll 8
                for (int r = 0; r < 256; ++r) s += bf1(tp[r * 258]);
                ((float*)(ws + WS_KMEAN))[((size_t)(b * 4 + (tid >> 6)) * 32 + blk) * 64 + (tid & 63)] = s * (1.0f / 256.0f); }
            continue;
        }
#pragma unroll 1
        for (int q = 0; q < 16; ++q) {
            const int Tq = w * 16 + q, c = (Tq & 7) * 32 + (lane & 31), pg = (Tq >> 3) * 2 + (lane >> 5);
            const int kbase = 16 * (pg >> 1) + 4 * (pg & 1);
            const LAS bf16* tp = (const LAS bf16*)T + c;
            float v[8];
#pragma unroll
            for (int j = 0; j < 8; ++j) { const int key = kbase + (j & 3) + 8 * (j >> 2); v[j] = bf1(tp[key * 258]); }
            if (kind == 3) { const float lg = a.lg2g[c >> 6];
#pragma unroll
                for (int j = 0; j < 8; ++j) { const int key = kbase + (j & 3) + 8 * (j >> 2); v[j] *= __builtin_amdgcn_exp2f(lg * (float)(255 - key)); } }
            u32x4 o; o.x = pk2(v[0], v[1]); o.y = pk2(v[2], v[3]); o.z = pk2(v[4], v[5]); o.w = pk2(v[6], v[7]);
            *(u32x4*)(dst + (size_t)c * SEQ + blk * 256 + pg * 8) = o;
        }
    }
    __syncthreads();
}

constexpr int MB_KROW = 144, MB_VROW = 528, MB_KBYTES = 256 * MB_KROW, MB_STAGE = MB_KBYTES + 64 * MB_VROW;
constexpr int MB_LIST = MB_STAGE, MB_MISC = MB_STAGE + 16384;
static_assert(MB_MISC + 64 <= LDS_BYTES - 64, "moba lds");
constexpr size_t OUT_PO = 128 * MiB, OUT_PM = 224 * MiB, OUT_SEL = 232 * MiB;
constexpr int CTR_WORD0 = 3584;

__device__ __forceinline__ void moba_tile(const LAS unsigned char* Kb, const LAS unsigned char* Vb, int t, const bf16x8 (&qf)[4], f32x16& O0, f32x16& O1, float& mx, float& l, bool diag, int qpos, int ql, int hh) {
    const float C = 1.44269504089f;
    f32x16 s0, s1;
#pragma unroll
    for (int i = 0; i < 16; ++i) { s0[i] = 0.f; s1[i] = 0.f; }
#pragma unroll
    for (int ks = 0; ks < 4; ++ks) {
        const bf16x8 a0 = *(const LAS bf16x8*)(Kb + (64 * t + ql) * MB_KROW + (16 * ks + 8 * hh) * 2);
        const bf16x8 a1 = *(const LAS bf16x8*)(Kb + (64 * t + 32 + ql) * MB_KROW + (16 * ks + 8 * hh) * 2);
        s0 = MFMA32(a0, qf[ks], s0); s1 = MFMA32(a1, qf[ks], s1);
    }
    if (diag) {
#pragma unroll
        for (int i = 0; i < 16; ++i) { const int kl = 64 * t + crow(i, hh); if (kl > qpos) s0[i] = -INFINITY; if (kl + 32 > qpos) s1[i] = -INFINITY; }
    }
    float tmax = fmaxf(s0[0], s1[0]);
#pragma unroll
    for (int i = 1; i < 16; ++i) tmax = fmaxf(tmax, fmaxf(s0[i], s1[i]));
    tmax = fmaxf(tmax, __shfl_xor(tmax, 32));
    float mxn = mx, alpha = 1.0f;
    if (!__all(tmax <= mx + 6.0f)) { mxn = fmaxf(mx, tmax); alpha = __builtin_amdgcn_exp2f((mx - mxn) * C); }
    const float mref = mxn * C;
    mx = mxn;
    float ls = 0.f;
#pragma unroll
    for (int i = 0; i < 16; ++i) { s0[i] = __builtin_amdgcn_exp2f(s0[i] * C - mref); s1[i] = __builtin_amdgcn_exp2f(s1[i] * C - mref); ls += s0[i] + s1[i]; }
    l = l * alpha + ls;
    if (__ballot(alpha != 1.0f) != 0ull) {
#pragma unroll
        for (int i = 0; i < 16; ++i) { O0[i] *= alpha; O1[i] *= alpha; }
    }
#pragma unroll
    for (int sb = 0; sb < 2; ++sb)
#pragma unroll
        for (int s2 = 0; s2 < 2; ++s2) {
            union { u32x4 u; bf16x8 v; } pb;
            if (sb == 0) { pb.u.x = pk2(s0[8 * s2], s0[8 * s2 + 1]); pb.u.y = pk2(s0[8 * s2 + 2], s0[8 * s2 + 3]); pb.u.z = pk2(s0[8 * s2 + 4], s0[8 * s2 + 5]); pb.u.w = pk2(s0[8 * s2 + 6], s0[8 * s2 + 7]); }
            else         { pb.u.x = pk2(s1[8 * s2], s1[8 * s2 + 1]); pb.u.y = pk2(s1[8 * s2 + 2], s1[8 * s2 + 3]); pb.u.z = pk2(s1[8 * s2 + 4], s1[8 * s2 + 5]); pb.u.w = pk2(s1[8 * s2 + 6], s1[8 * s2 + 7]); }
            const int kp = 64 * t + 32 * sb + 16 * s2 + 8 * hh;
            const bf16x8 v0 = *(const LAS bf16x8*)(Vb + ql * MB_VROW + kp * 2);
            const bf16x8 v1 = *(const LAS bf16x8*)(Vb + (32 + ql) * MB_VROW + kp * 2);
            O0 = MFMA32(v0, pb.v, O0); O1 = MFMA32(v1, pb.v, O1);
        }
}

#define MB_SOFT(s0, s1, mx, l, O0, O1) do { \
    float tmax_ = fmaxf(s0[0], s1[0]); _Pragma("unroll") for (int i = 1; i < 16; ++i) tmax_ = fmaxf(tmax_, fmaxf(s0[i], s1[i])); \
    tmax_ = fmaxf(tmax_, __shfl_xor(tmax_, 32)); float mxn_ = mx, alpha_ = 1.0f; if (!__all(tmax_ <= mx + 6.0f)) { mxn_ = fmaxf(mx, tmax_); alpha_ = __builtin_amdgcn_exp2f((mx - mxn_) * C); } const float mref_ = mxn_ * C; mx = mxn_; \
    float ls_ = 0.f; _Pragma("unroll") for (int i = 0; i < 16; ++i) { s0[i] = __builtin_amdgcn_exp2f(s0[i] * C - mref_); s1[i] = __builtin_amdgcn_exp2f(s1[i] * C - mref_); ls_ += s0[i] + s1[i]; } \
    l = l * alpha_ + ls_; if (__ballot(alpha_ != 1.0f) != 0ull) { _Pragma("unroll") for (int i = 0; i < 16; ++i) { O0[i] *= alpha_; O1[i] *= alpha_; } } } while (0)
#define MB_PACK(dst, s, s2) do { dst.u.x = pk2(s[8 * (s2)], s[8 * (s2) + 1]); dst.u.y = pk2(s[8 * (s2) + 2], s[8 * (s2) + 3]); dst.u.z = pk2(s[8 * (s2) + 4], s[8 * (s2) + 5]); dst.u.w = pk2(s[8 * (s2) + 6], s[8 * (s2) + 7]); } while (0)
__device__ __forceinline__ void moba_tile2(const LAS unsigned char* Kb, const LAS unsigned char* Vb, int t, const bf16x8 (&qa)[4], const bf16x8 (&qb)[4],
                                           f32x16& A0, f32x16& A1, f32x16& B0, f32x16& B1, float& mxa, float& la, float& mxb, float& lb, int ql, int hh) {
    const float C = 1.44269504089f;
    f32x16 sa0, sa1, sb0, sb1;
#pragma unroll
    for (int i = 0; i < 16; ++i) { sa0[i] = 0.f; sa1[i] = 0.f; sb0[i] = 0.f; sb1[i] = 0.f; }
#pragma unroll
    for (int ks = 0; ks < 4; ++ks) {
        const bf16x8 a0 = *(const LAS bf16x8*)(Kb + (64 * t + ql) * MB_KROW + (16 * ks + 8 * hh) * 2);
        const bf16x8 a1 = *(const LAS bf16x8*)(Kb + (64 * t + 32 + ql) * MB_KROW + (16 * ks + 8 * hh) * 2);
        sa0 = MFMA32(a0, qa[ks], sa0); sa1 = MFMA32(a1, qa[ks], sa1); sb0 = MFMA32(a0, qb[ks], sb0); sb1 = MFMA32(a1, qb[ks], sb1);
    }
    MB_SOFT(sa0, sa1, mxa, la, A0, A1);
    MB_SOFT(sb0, sb1, mxb, lb, B0, B1);
#pragma unroll
    for (int sb = 0; sb < 2; ++sb)
#pragma unroll
        for (int s2 = 0; s2 < 2; ++s2) {
            union { u32x4 u; bf16x8 v; } pa, pb;
            if (sb == 0) { MB_PACK(pa, sa0, s2); MB_PACK(pb, sb0, s2); } else { MB_PACK(pa, sa1, s2); MB_PACK(pb, sb1, s2); }
            const int kp = 64 * t + 32 * sb + 16 * s2 + 8 * hh;
            const bf16x8 v0 = *(const LAS bf16x8*)(Vb + ql * MB_VROW + kp * 2);
            const bf16x8 v1 = *(const LAS bf16x8*)(Vb + (32 + ql) * MB_VROW + kp * 2);
            A0 = MFMA32(v0, pa.v, A0); A1 = MFMA32(v1, pa.v, A1); B0 = MFMA32(v0, pb.v, B0); B1 = MFMA32(v1, pb.v, B1);
        }
}
__device__ __forceinline__ void moba_put_partial(bf16* PO, float* PM, size_t pidx, const f32x16& O0, const f32x16& O1, float mx, float l, int hh) {
    const float inv = 1.0f / l;
    bf16* po = PO + pidx * 64 + 4 * hh;
#pragma unroll
    for (int i4 = 0; i4 < 4; ++i4) {
        u32x2 o0, o1;
        o0.x = pk2(O0[4 * i4] * inv, O0[4 * i4 + 1] * inv); o0.y = pk2(O0[4 * i4 + 2] * inv, O0[4 * i4 + 3] * inv);
        o1.x = pk2(O1[4 * i4] * inv, O1[4 * i4 + 1] * inv); o1.y = pk2(O1[4 * i4 + 2] * inv, O1[4 * i4 + 3] * inv);
        *(u32x2*)(po + 8 * i4) = o0; *(u32x2*)(po + 32 + 8 * i4) = o1;
    }
    if (hh == 0) { PM[pidx * 2] = mx; PM[pidx * 2 + 1] = l; }
}
#define MB_STAGE_LOAD(Kg, Vg, m) u32x4 sk_[4], sv_[4]; _Pragma("unroll") for (int c = 0; c < 4; ++c) { const int ch = tl + NTHR * c; \
        sk_[c] = *(const u32x4*)((Kg) + (size_t)((m) * 256 + (ch >> 3)) * INC + (ch & 7) * 8); sv_[c] = *(const u32x4*)((Vg) + (size_t)(ch >> 5) * SEQ + (m) * 256 + (ch & 31) * 8); }
#define MB_STAGE_STORE() do { _Pragma("unroll") for (int c = 0; c < 4; ++c) { const int ch = tl + NTHR * c; *(LAS u32x4*)(lds + (ch >> 3) * MB_KROW + (ch & 7) * 16) = sk_[c]; *(LAS u32x4*)(lds + MB_KBYTES + (ch >> 5) * MB_VROW + (ch & 31) * 16) = sv_[c]; } } while (0)

__device__ __forceinline__ void moba_gate_phase(const Args& a, LAS unsigned char* lds, int tid, int G, unsigned char* ws_, unsigned char* outb_) {
    unsigned char* ws = ws_; unsigned char* outb = outb_; (void)outb; const bf16* Z = (const bf16*)(ws + WS_HZ); const float* km = (const float*)(ws + WS_KMEAN); unsigned* SEL = (unsigned*)(outb + OUT_SEL);
    const int lane = tid & 63, w = tid >> 6, ql = lane & 31, hh = lane >> 5;
    for (int e = blockIdx.x; e < BATCH * 4 * 32; e += G) {
        const int bh = e & 31, n = e >> 5, b = bh >> 2, h = bh & 3;
        const size_t rowq = (size_t)b * SEQ + n * 256 + w * 32 + ql;
        unsigned* selp = SEL + (size_t)bh * SEQ + n * 256 + w * 32 + ql;
        if (n == 0) { if (hh == 0) *selp = 0xFFFFFFu; continue; }
        __syncthreads();
        { const f32x4 v = *(const f32x4*)(km + (size_t)bh * 2048 + tid * 4); *(LAS f32x4*)(lds + tid * 16) = v; }
        float q[64];
        { const u32x4* qp = (const u32x4*)(Z + rowq * INC + ZMQ + h * 64);
#pragma unroll
          for (int c = 0; c < 8; ++c) { const u32x4 wv = qp[c]; q[8 * c] = bflo(wv.x); q[8 * c + 1] = bfhi(wv.x); q[8 * c + 2] = bflo(wv.y); q[8 * c + 3] = bfhi(wv.y); q[8 * c + 4] = bflo(wv.z); q[8 * c + 5] = bfhi(wv.z); q[8 * c + 6] = bflo(wv.w); q[8 * c + 7] = bfhi(wv.w); } }
        __syncthreads();
        float g0 = -INFINITY, g1 = -INFINITY, g2 = -INFINITY; int i0 = 255, i1 = 255, i2 = 255;
#define MB_INS(g, m) do { if ((g) > g0 || ((g) == g0 && (m) < i0)) { g2 = g1; i2 = i1; g1 = g0; i1 = i0; g0 = (g); i0 = (m); } \
        else if ((g) > g1 || ((g) == g1 && (m) < i1)) { g2 = g1; i2 = i1; g1 = (g); i1 = (m); } \
        else if ((g) > g2 || ((g) == g2 && (m) < i2)) { g2 = (g); i2 = (m); } } while (0)
        const int mend = (n < 16 * hh + 16) ? n : 16 * hh + 16;
        for (int m = 16 * hh; m < mend; ++m) {
            const LAS f32x4* kp = (const LAS f32x4*)(lds + m * 256);
            float g = 0.f;
#pragma unroll
            for (int c = 0; c < 16; ++c) { const f32x4 kv = kp[c]; g += q[4 * c] * kv[0] + q[4 * c + 1] * kv[1] + q[4 * c + 2] * kv[2] + q[4 * c + 3] * kv[3]; }
            MB_INS(g, m);
        }
        const float pg0 = __shfl_xor(g0, 32), pg1 = __shfl_xor(g1, 32), pg2 = __shfl_xor(g2, 32);
        const int pi0 = __shfl_xor(i0, 32), pi1 = __shfl_xor(i1, 32), pi2 = __shfl_xor(i2, 32);
        if (pi0 < 255) MB_INS(pg0, pi0);
        if (pi1 < 255) MB_INS(pg1, pi1);
        if (pi2 < 255) MB_INS(pg2, pi2);
#undef MB_INS
        if (hh == 0) *selp = (unsigned)i0 | ((unsigned)i1 << 8) | ((unsigned)i2 << 16);
    }
    __syncthreads();
}

__device__ __forceinline__ void moba_past_phase(const Args& a, int L, LAS unsigned char* lds, int tid, int G, unsigned char* ws_, unsigned char* outb_) {
    unsigned char* ws = ws_; unsigned char* outb = outb_; (void)outb; const bf16* Z = (const bf16*)(ws + WS_HZ); const bf16* VTM = (const bf16*)((const unsigned char*)outb + OUT_VTM);
    const unsigned* SEL = (const unsigned*)((const unsigned char*)outb + OUT_SEL); bf16* PO = (bf16*)(outb + OUT_PO); float* PM = (float*)(outb + OUT_PM);
    unsigned* ctr = (unsigned*)ws + CTR_WORD0 + 64 * L;
    const int lane = tid & 63, w = tid >> 6, ql = lane & 31, hh = lane >> 5;
    LAS unsigned short* list = (LAS unsigned short*)(lds + MB_LIST); LAS unsigned* misc = (LAS unsigned*)(lds + MB_MISC);
    for (;;) {
        __syncthreads();
        if (tid == 0) { misc[0] = __hip_atomic_fetch_add(ctr, 1u, __ATOMIC_RELAXED, __HIP_MEMORY_SCOPE_AGENT); misc[1] = 0u; }
        __syncthreads();
        const int e = (int)misc[0];
        if (e >= 31 * 32) break;
        const int m = e >> 5, bh = e & 31, b = bh >> 2, h = bh & 3;
        int tl = tid; asm volatile("" : "+v"(tl));
        const bf16* Kg = Z + (size_t)b * SEQ * INC + ZMK + h * 64; const bf16* Vg = VTM + ((size_t)b * 256 + h * 64) * SEQ;
        MB_STAGE_LOAD(Kg, Vg, m);
        for (int s0 = (m + 1) * 256 + tl; s0 < SEQ; s0 += 4 * NTHR) {
            unsigned sv4[4];
#pragma unroll
            for (int u = 0; u < 4; ++u) { const int s = s0 + u * NTHR; sv4[u] = (s < SEQ) ? SEL[(size_t)bh * SEQ + s] : 0xFFFFFFu; }
#pragma unroll
            for (int u = 0; u < 4; ++u) { const int s = s0 + u * NTHR; const unsigned sel = sv4[u];
#pragma unroll
                for (int t = 0; t < 3; ++t) if (((sel >> (8 * t)) & 0xFFu) == (unsigned)m) { const unsigned pos = __hip_atomic_fetch_add((unsigned*)(misc + 1), 1u, __ATOMIC_RELAXED, __HIP_MEMORY_SCOPE_WORKGROUP); list[pos] = (unsigned short)(s | (t << 13)); } }
        }
        MB_STAGE_STORE();
        __syncthreads();
        const int cnt = (int)misc[1];
        for (int c0 = 0; c0 < cnt; c0 += 512) {
            const int ia = c0 + w * 64 + ql, ib = ia + 32;
            if (c0 + w * 64 >= cnt) continue;
            const bool va = ia < cnt, vb = ib < cnt, two = (c0 + w * 64 + 32) < cnt;
            const unsigned ea = list[va ? ia : cnt - 1], eb = list[vb ? ib : cnt - 1];
            bf16x8 qa[4], qb[4];
#pragma unroll
            for (int ks = 0; ks < 4; ++ks) { qa[ks] = *(const bf16x8*)(Z + ((size_t)b * SEQ + (ea & 8191)) * INC + ZMQ + h * 64 + ks * 16 + hh * 8);
                                             qb[ks] = *(const bf16x8*)(Z + ((size_t)b * SEQ + (eb & 8191)) * INC + ZMQ + h * 64 + ks * 16 + hh * 8); }
            f32x16 A0, A1, B0, B1;
#pragma unroll
            for (int i = 0; i < 16; ++i) { A0[i] = 0.f; A1[i] = 0.f; B0[i] = 0.f; B1[i] = 0.f; }
            float mxa = -1e30f, la = 0.f, mxb = -1e30f, lb = 0.f;
            if (two) {
#pragma unroll 1
                for (int t = 0; t < 4; ++t) moba_tile2(lds, lds + MB_KBYTES, t, qa, qb, A0, A1, B0, B1, mxa, la, mxb, lb, ql, hh);
            } else {
#pragma unroll 1
                for (int t = 0; t < 4; ++t) moba_tile(lds, lds + MB_KBYTES, t, qa, A0, A1, mxa, la, false, 0, ql, hh);
            }
            la += __shfl_xor(la, 32); lb += __shfl_xor(lb, 32);
            if (va) moba_put_partial(PO, PM, ((size_t)bh * SEQ + (ea & 8191)) * 3 + (ea >> 13), A0, A1, mxa, la, hh);
            if (two && vb) moba_put_partial(PO, PM, ((size_t)bh * SEQ + (eb & 8191)) * 3 + (eb >> 13), B0, B1, mxb, lb, hh);
        }
    }
    __syncthreads();
}

__device__ __forceinline__ void moba_own_phase(const Args& a, LAS unsigned char* lds, int tid, int G, unsigned char* ws_, unsigned char* outb_) {
    unsigned char* ws = ws_; unsigned char* outb = outb_; (void)outb; const bf16* Z = (const bf16*)(ws + WS_HZ); bf16* Y = (bf16*)(ws + WS_Y); const bf16* VTM = (const bf16*)((const unsigned char*)outb + OUT_VTM);
    const bf16* PO = (const bf16*)((const unsigned char*)outb + OUT_PO); const float* PM = (const float*)((const unsigned char*)outb + OUT_PM);
    const int lane = tid & 63, w = tid >> 6, ql = lane & 31, hh = lane >> 5;
    const float C = 1.44269504089f;
    for (int e = blockIdx.x; e < BATCH * 4 * 32; e += G) {
        const int bh = e & 31, n = e >> 5, b = bh >> 2, h = bh & 3;
        const int sq = n * 256 + w * 32 + ql; const size_t rowq = (size_t)b * SEQ + sq;
        __syncthreads();
        int tl = tid; asm volatile("" : "+v"(tl));
        const bf16* Kg = Z + (size_t)b * SEQ * INC + ZMK + h * 64; const bf16* Vg = VTM + ((size_t)b * 256 + h * 64) * SEQ;
        MB_STAGE_LOAD(Kg, Vg, n);
        bf16x8 qf[4];
#pragma unroll
        for (int ks = 0; ks < 4; ++ks) qf[ks] = *(const bf16x8*)(Z + rowq * INC + ZMQ + h * 64 + ks * 16 + hh * 8);
        MB_STAGE_STORE();
        __syncthreads();
        f32x16 O0, O1;
#pragma unroll
        for (int i = 0; i < 16; ++i) { O0[i] = 0.f; O1[i] = 0.f; }
        float mx = -1e30f, l = 0.f;
        const int qpos = w * 32 + ql, nt = (w >> 1) + 1;
#pragma unroll 1
        for (int t = 0; t < nt; ++t) moba_tile(lds, lds + MB_KBYTES, t, qf, O0, O1, mx, l, t == nt - 1, qpos, ql, hh);
        l += __shfl_xor(l, 32);
        const int nsel = n < 3 ? n : 3;
        const size_t pbase = ((size_t)bh * SEQ + sq) * 3;
        float mt[3], lt[3], M = mx;
#pragma unroll
        for (int t = 0; t < 3; ++t) { mt[t] = -1e30f; lt[t] = 0.f; if (t < nsel) { mt[t] = PM[(pbase + t) * 2]; lt[t] = PM[(pbase + t) * 2 + 1]; M = fmaxf(M, mt[t]); } }
        const float wo = __builtin_amdgcn_exp2f((mx - M) * C);
        float Lsum = l * wo;
#pragma unroll
        for (int i = 0; i < 16; ++i) { O0[i] *= wo; O1[i] *= wo; }
#pragma unroll
        for (int t = 0; t < 3; ++t) if (t < nsel) {
            const float wt = __builtin_amdgcn_exp2f((mt[t] - M) * C) * lt[t]; Lsum += wt;
            const bf16* po = PO + (pbase + t) * 64 + 4 * hh;
#pragma unroll
            for (int i4 = 0; i4 < 4; ++i4) { const u32x2 p0 = *(const u32x2*)(po + 8 * i4), p1 = *(const u32x2*)(po + 32 + 8 * i4);
                O0[4 * i4] += wt * bflo(p0.x); O0[4 * i4 + 1] += wt * bfhi(p0.x); O0[4 * i4 + 2] += wt * bflo(p0.y); O0[4 * i4 + 3] += wt * bfhi(p0.y);
                O1[4 * i4] += wt * bflo(p1.x); O1[4 * i4 + 1] += wt * bfhi(p1.x); O1[4 * i4 + 2] += wt * bflo(p1.y); O1[4 * i4 + 3] += wt * bfhi(p1.y); }
        }
        const float inv = 1.0f / Lsum;
        bf16* yp = Y + rowq * D + 768 + h * 64 + 4 * hh;
#pragma unroll
        for (int i4 = 0; i4 < 4; ++i4) {
            u32x2 o0, o1;
            o0.x = pk2(O0[4 * i4] * inv, O0[4 * i4 + 1] * inv); o0.y = pk2(O0[4 * i4 + 2] * inv, O0[4 * i4 + 3] * inv);
            o1.x = pk2(O1[4 * i4] * inv, O1[4 * i4 + 1] * inv); o1.y = pk2(O1[4 * i4 + 2] * inv, O1[4 * i4 + 3] * inv);
            *(u32x2*)(yp + 8 * i4) = o0; *(u32x2*)(yp + 32 + 8 * i4) = o1;
        }
    }
    __syncthreads();
}

__device__ __forceinline__ void ret_kv_phase(const Args& a, int tid, int G, unsigned char* ws_, unsigned char* outb_) {
    unsigned char* ws = ws_; unsigned char* outb = outb_; (void)outb; const bf16* VTR = (const bf16*)((const unsigned char*)outb + OUT_VTR); const bf16* KTZ = (const bf16*)((const unsigned char*)outb + OUT_KTZ); float* KV = (float*)(ws + WS_KV);
    const int lane = tid & 63, w = tid >> 6, ql = lane & 31, hh = lane >> 5, eb = w >> 1, db = w & 1;
    for (int it = blockIdx.x; it < BATCH * 4 * 32; it += G) {
        const int j = it & 31, h = (it >> 5) & 3, b = it >> 7;
        const bf16* ap = VTR + ((size_t)b * 512 + h * 128 + eb * 32 + ql) * SEQ + j * 256 + 8 * hh;
        const bf16* bp = KTZ + ((size_t)b * 256 + h * 64 + db * 32 + ql) * SEQ + j * 256 + 8 * hh;
        f32x16 acc;
#pragma unroll
        for (int i = 0; i < 16; ++i) acc[i] = 0.f;
#pragma unroll
        for (int half = 0; half < 2; ++half) {
            bf16x8 av[8], bv[8];
#pragma unroll
            for (int s = 0; s < 8; ++s) { av[s] = *(const bf16x8*)(ap + (half * 8 + s) * 16); bv[s] = *(const bf16x8*)(bp + (half * 8 + s) * 16); }
#pragma unroll
            for (int s = 0; s < 8; ++s) acc = MFMA32(av[s], bv[s], acc);
        }
        float* o = KV + (size_t)it * 8192 + (size_t)(eb * 32) * 64 + db * 32 + ql;
#pragma unroll
        for (int i = 0; i < 16; ++i) o[crow(i, hh) * 64] = acc[i];
    }
}
__device__ __forceinline__ void ret_scan_phase(const Args& a, int tid, int G, unsigned char* ws_, unsigned char* outb_) {
    unsigned char* ws = ws_; unsigned char* outb = outb_; (void)outb; const float* KV = (const float*)(ws + WS_KV); bf16* RSb = (bf16*)(ws + WS_RS);
    for (int i = blockIdx.x * NTHR + tid; i < 32 * 4096; i += G * NTHR) {
        const int bh = i >> 12, el = (i & 4095) * 2; const float gC = __builtin_amdgcn_exp2f(a.lg2g[bh & 3] * 256.0f);
        float S0 = 0.f, S1 = 0.f;
        for (int j = 0; j < 32; ++j) { const size_t o = ((size_t)bh * 32 + j) * 8192 + el; *(unsigned*)(RSb + o) = pk2(S0, S1); const float k0 = KV[o], k1 = KV[o + 1]; S0 = gC * S0 + k0; S1 = gC * S1 + k1; }
    }
}
constexpr int RT_KROW = 144, RT_VROW = 528, RT_KBYTES = 256 * RT_KROW;
static_assert(RT_KBYTES + 128 * RT_VROW <= LDS_BYTES, "ret lds");
__device__ __forceinline__ void ret_out_phase(const Args& a, LAS unsigned char* lds, int tid, int G, unsigned char* ws_, unsigned char* outb_) {
    unsigned char* ws = ws_; unsigned char* outb = outb_; (void)outb;
    const bf16* Z = (const bf16*)(ws + WS_HZ); bf16* Y = (bf16*)(ws + WS_Y); const bf16* VTR = (const bf16*)((const unsigned char*)outb + OUT_VTR); const bf16* RSb = (const bf16*)(ws + WS_RS);
    const int lane = tid & 63, w = tid >> 6, ql = lane & 31, hh = lane >> 5;
    for (int it = blockIdx.x; it < BATCH * 4 * 32; it += G) {
        const int j = it & 31, h = (it >> 5) & 3, b = it >> 7;
        const size_t rowc = (size_t)b * SEQ + j * 256, rowq = rowc + w * 32 + ql;
        const float lg = a.lg2g[h];
        __syncthreads();
        int tl = tid; asm volatile("" : "+v"(tl));
        u32x4 stk[4], stv[8];
#pragma unroll
        for (int c = 0; c < 4; ++c) { const int ch = tl + NTHR * c; stk[c] = *(const u32x4*)(Z + (rowc + (ch >> 3)) * INC + ZK + h * 64 + (ch & 7) * 8); }
#pragma unroll
        for (int c = 0; c < 8; ++c) { const int ch = tl + NTHR * c; stv[c] = *(const u32x4*)(VTR + ((size_t)b * 512 + h * 128 + (ch >> 5)) * SEQ + j * 256 + (ch & 31) * 8); }
        bf16x8 qf[4];
#pragma unroll
        for (int ks = 0; ks < 4; ++ks) qf[ks] = *(const bf16x8*)(Z + rowq * INC + ZQ + h * 64 + ks * 16 + hh * 8);
        f32x16 O[4];
#pragma unroll
        for (int eb = 0; eb < 4; ++eb) {
#pragma unroll
            for (int i = 0; i < 16; ++i) O[eb][i] = 0.f;
            const bf16* rp = RSb + (size_t)it * 8192 + (size_t)(eb * 32 + ql) * 64 + 8 * hh;
#pragma unroll
            for (int ks = 0; ks < 4; ++ks) { const bf16x8 ra = *(const bf16x8*)(rp + ks * 16); O[eb] = MFMA32(ra, qf[ks], O[eb]); }
            __builtin_amdgcn_sched_barrier(0);
        }
        const int qpos = w * 32 + ql;
        { const float xi = __builtin_amdgcn_exp2f(lg * (float)(qpos + 1));
#pragma unroll
          for (int eb = 0; eb < 4; ++eb)
#pragma unroll
              for (int i = 0; i < 16; ++i) O[eb][i] *= xi; }
#pragma unroll
        for (int c = 0; c < 4; ++c) { const int ch = tl + NTHR * c; *(LAS u32x4*)(lds + (ch >> 3) * RT_KROW + (ch & 7) * 16) = stk[c]; }
#pragma unroll
        for (int c = 0; c < 8; ++c) { const int ch = tl + NTHR * c; *(LAS u32x4*)(lds + RT_KBYTES + (ch >> 5) * RT_VROW + (ch & 31) * 16) = stv[c]; }
        __syncthreads();
        for (int kb = 0; kb <= w; ++kb) {
            f32x16 s;
#pragma unroll
            for (int i = 0; i < 16; ++i) s[i] = 0.f;
#pragma unroll
            for (int ks = 0; ks < 4; ++ks) { const bf16x8 ka = *(const LAS bf16x8*)(lds + (32 * kb + ql) * RT_KROW + (16 * ks + 8 * hh) * 2); s = MFMA32(ka, qf[ks], s); }
#pragma unroll
            for (int i = 0; i < 16; ++i) { const int diff = qpos - 32 * kb - crow(i, hh); const float fdec = __builtin_amdgcn_exp2f(lg * (float)diff); s[i] = diff >= 0 ? s[i] * fdec : 0.f; }
#pragma unroll
            for (int s2 = 0; s2 < 2; ++s2) {
                union { u32x4 u; bf16x8 v; } pb;
                pb.u.x = pk2(s[8 * s2], s[8 * s2 + 1]); pb.u.y = pk2(s[8 * s2 + 2], s[8 * s2 + 3]); pb.u.z = pk2(s[8 * s2 + 4], s[8 * s2 + 5]); pb.u.w = pk2(s[8 * s2 + 6], s[8 * s2 + 7]);
                const int kp = 32 * kb + 16 * s2 + 8 * hh;
#pragma unroll
                for (int eb = 0; eb < 4; ++eb) { const bf16x8 va = *(const LAS bf16x8*)(lds + RT_KBYTES + (eb * 32 + ql) * RT_VROW + kp * 2); O[eb] = MFMA32(va, pb.v, O[eb]); }
            }
        }
        float s1 = 0.f;
#pragma unroll
        for (int eb = 0; eb < 4; ++eb)
#pragma unroll
            for (int i = 0; i < 16; ++i) s1 += O[eb][i];
        s1 += __shfl_xor(s1, 32);
        const float mean = s1 * (1.0f / 128.0f); float s2 = 0.f;
#pragma unroll
        for (int eb = 0; eb < 4; ++eb)
#pragma unroll
            for (int i = 0; i < 16; ++i) { O[eb][i] -= mean; s2 += O[eb][i] * O[eb][i]; }
        s2 += __shfl_xor(s2, 32);
        const float rstd = 1.0f / sqrtf(s2 * (1.0f / 128.0f) + 1e-6f);
        const bf16* gp = Z + rowq * INC + ZG + h * 128 + 4 * hh; bf16* yp = Y + rowq * D + h * 128 + 4 * hh;
#pragma unroll
        for (int eb = 0; eb < 4; ++eb)
#pragma unroll
            for (int i4 = 0; i4 < 4; ++i4) {
                const u32x2 gw = *(const u32x2*)(gp + eb * 32 + 8 * i4);
                const float r0 = O[eb][4 * i4] * rstd * pg8::silu_f(bflo(gw.x)), r1 = O[eb][4 * i4 + 1] * rstd * pg8::silu_f(bfhi(gw.x)),
                            r2 = O[eb][4 * i4 + 2] * rstd * pg8::silu_f(bflo(gw.y)), r3 = O[eb][4 * i4 + 3] * rstd * pg8::silu_f(bfhi(gw.y));
                u32x2 o; o.x = pk2(r0, r1); o.y = pk2(r2, r3); *(u32x2*)(yp + eb * 32 + 8 * i4) = o;
            }
    }
    __syncthreads();
}

__device__ __forceinline__ void phase_m1(const Args& a, int L, LAS unsigned char* lds, int tid, int G, unsigned char* ws_, unsigned char* outb_) {
    unsigned char* ws = ws_; unsigned char* outb = outb_; (void)outb;
    const bf16* Z = (const bf16*)(ws + WS_HZ); bf16* Y = (bf16*)(ws + WS_Y);
    const int lane = tid & 63, w = tid >> 6, ql = lane & 31, hh = lane >> 5, g = w >> 1, db = w & 1;
    LAS bf16* U = (LAS bf16*)lds;
    LAS bf16* Pb = (LAS bf16*)(lds + 24576);
    const float* pw = a.in[8] + (size_t)L * 4 * 64 * 64; const float scl = a.in[9][L * 256 + g * 64 + db * 32 + ql];
    bf16x8 wb[4];
#pragma unroll
    for (int ks = 0; ks < 4; ++ks) { float v[8];
#pragma unroll
        for (int j = 0; j < 8; ++j) v[j] = pw[(size_t)(g * 64 + ks * 16 + hh * 8 + j) * 64 + db * 32 + ql];
        union { u32x4 u; bf16x8 b; } t; t.u.x = pk2(v[0], v[1]); t.u.y = pk2(v[2], v[3]); t.u.z = pk2(v[4], v[5]); t.u.w = pk2(v[6], v[7]); wb[ks] = t.b; }
    for (int tile = blockIdx.x; tile < M / 32; tile += G) {
        const int r0 = tile * 32, sp0 = r0 & (SEQ - 1);
        __syncthreads();
        for (int c = tid; c < 47 * 32; c += NTHR) { const int i = c >> 5, cc = c & 31;
            if (sp0 + i - 15 >= 0) *(LAS u32x4*)(U + i * 256 + cc * 8) = *(const u32x4*)(Z + (size_t)(r0 + i - 15) * INC + ZP + cc * 8); }
        __syncthreads();
#pragma unroll 4
        for (int k = 0; k < 16; ++k) {
            const int idx = tid + NTHR * k, t = idx >> 8, ch = idx & 255, win = 2 << (ch >> 6);
            const int sp = sp0 + t; const int nb = (sp + 1 < win) ? (sp + 1) : win;
            const LAS bf16* up = U + (15 + t) * 256 + ch;
            float s = 0.f;
#pragma unroll
            for (int ww = 0; ww < 16; ++ww) if (ww < nb) s += bf1(up[-ww * 256]);
            Pb[t * 264 + ch] = (bf16)f2bf(s / (float)nb - bf1(up[0]));
        }
        __syncthreads();
        f32x16 acc;
#pragma unroll
        for (int i = 0; i < 16; ++i) acc[i] = 0.f;
#pragma unroll
        for (int ks = 0; ks < 4; ++ks) { const bf16x8 pa = *(const LAS bf16x8*)(Pb + ql * 264 + g * 64 + ks * 16 + hh * 8); acc = MFMA32(pa, wb[ks], acc); }
        bf16* yp = Y + (size_t)r0 * D + 512 + g * 64 + db * 32 + ql;
#pragma unroll
        for (int i = 0; i < 16; ++i) yp[(size_t)crow(i, hh) * D] = (bf16)f2bf(acc[i] * scl);
    }
    __syncthreads();
}

__device__ __forceinline__ void phase_final(const Args& a, int lane, int wave, int G) {
    const float* g = a.in[18]; float* xo = a.out; const bf16* xb = (const bf16*)(a.ws + WS_XB2);
    const int gw = blockIdx.x * NWAVES + wave, NGW = G * NWAVES;
    const f32x4* gp = (const f32x4*)g + lane;
    for (int m = gw; m < M; m += NGW) {
        const u32x2* br = (const u32x2*)(xb + (size_t)m * D) + lane; f32x4* xr = (f32x4*)(xo + (size_t)m * D) + lane; f32x4 v[4]; float s = 0.f;
#pragma unroll
        for (int j = 0; j < 4; ++j) { const u32x2 w = br[64 * j]; v[j][0] = bflo(w.x); v[j][1] = bfhi(w.x); v[j][2] = bflo(w.y); v[j][3] = bfhi(w.y); s += (v[j][0] * v[j][0] + v[j][1] * v[j][1]) + (v[j][2] * v[j][2] + v[j][3] * v[j][3]); }
        const float r = 1.0f / sqrtf(wave_sum(s) * (1.0f / D) + 1e-6f);
#pragma unroll
        for (int j = 0; j < 4; ++j) xr[64 * j] = v[j] * r * gp[64 * j];
    }
}

#define RLX_AGENT __ATOMIC_RELAXED, __HIP_MEMORY_SCOPE_AGENT
#define XB_TMO      128
#define XB_XCNT(j)  (256  + 64 * (j))
#define XB_XSUB(j)  (1280 + 64 * (j))
#define XB_XGEN(j)  (2304 + 64 * (j))
#define XB_TOP      3328
#define XB_TOPGEN   3392
#define XCD_BAR_WORDS 3456
#define XB_SPIN_CAP (1u << 18)

__device__ __forceinline__ unsigned xb_ld(unsigned* p)              { return __hip_atomic_load(p, __ATOMIC_RELAXED, __HIP_MEMORY_SCOPE_AGENT); }
__device__ __forceinline__ unsigned xb_add(unsigned* p, unsigned v) { return __hip_atomic_fetch_add(p, v, __ATOMIC_RELAXED, __HIP_MEMORY_SCOPE_AGENT); }
__device__ __forceinline__ unsigned xb_xcc_id() { return (unsigned)__builtin_amdgcn_s_getreg((3 << 11) | 20) & 0xFu; }
#define XB_SPIN(cond, bar) do { unsigned _sp = 0; while (cond) { __builtin_amdgcn_s_sleep(1); \
    if ((++_sp & 255u) == 0u) { if (xb_ld(&(bar)[XB_TMO])) break; if (_sp > XB_SPIN_CAP) { atomicAdd(&(bar)[XB_TMO], 1u); break; } } } } while (0)

struct XcdBarrier {
    unsigned* bar; unsigned x;
    volatile LAS unsigned* st;
};

__device__ __forceinline__ XcdBarrier xcd_barrier_post(unsigned* bar, volatile LAS unsigned* st) {
    XcdBarrier b; b.bar = bar; b.x = xb_xcc_id(); b.st = st;
    if (threadIdx.x == 0) (void)xb_add(&bar[XB_XCNT(b.x)], 1u);
    return b;
}
__device__ __forceinline__ void xcd_barrier_complete(unsigned* bar, unsigned x, unsigned& nloc, unsigned& nx) {
    const unsigned G = gridDim.x * gridDim.y * gridDim.z;
    unsigned sum, cnt, mine, sp = 0u;
    for (;;) {
        sum = 0u; cnt = 0u; mine = 0u;
#pragma unroll
        for (unsigned j = 0; j < 16; ++j) { const unsigned c = xb_ld(&bar[XB_XCNT(j)]); sum += c; cnt += (c > 0u) ? 1u : 0u; mine = (j == x) ? c : mine; }
        if (sum == G) break;
        __builtin_amdgcn_s_sleep(1);
        if ((++sp & 255u) == 0u) { if (xb_ld(&bar[XB_TMO])) break; if (sp > XB_SPIN_CAP) { atomicAdd(&bar[XB_TMO], 1u); break; } }
    }
    nloc = mine > 0u ? mine : 1u; nx = cnt > 0u ? cnt : 1u;
}

__device__ __noinline__ void xcd_barrier_fn(unsigned* bar_, volatile LAS unsigned* st_) {
    XcdBarrier b; b.bar = bar_; b.x = xb_xcc_id(); b.st = st_;
    asm volatile("s_waitcnt vmcnt(0)" ::: "memory");
    __syncthreads();
    if (threadIdx.x == 0) {
        unsigned* bar = b.bar;
        __builtin_amdgcn_s_waitcnt(0);
        unsigned nloc = b.st[0], nx = b.st[1];
        if (nloc == 0u) { xcd_barrier_complete(bar, b.x, nloc, nx); b.st[0] = nloc; b.st[1] = nx; }
        const unsigned old = xb_add(&bar[XB_XSUB(b.x)], 1u);
        const unsigned gen = old / nloc;
        if (old + 1u == (gen + 1u) * nloc) {
            __builtin_amdgcn_fence(__ATOMIC_RELEASE, "agent");
            asm volatile("s_waitcnt vmcnt(0)" ::: "memory");
            const unsigned og = xb_add(&bar[XB_TOP], 1u);
            const unsigned tg = og / nx;
            if (og + 1u == (tg + 1u) * nx) xb_add(&bar[XB_TOPGEN], 1u);
            else XB_SPIN(xb_ld(&bar[XB_TOPGEN]) == tg, bar);
            __builtin_amdgcn_fence(__ATOMIC_ACQUIRE, "agent");
            xb_add(&bar[XB_XGEN(b.x)], 1u);
            asm volatile("s_waitcnt vmcnt(0)" ::: "memory");
        } else {
            XB_SPIN(xb_ld(&bar[XB_XGEN(b.x)]) == gen, bar);
            __builtin_amdgcn_fence(__ATOMIC_ACQUIRE, "agent");
            asm volatile("s_waitcnt vmcnt(0)" ::: "memory");
        }
    }
    __syncthreads();
}

constexpr int N_PHASES = 2 + 11 * DEPTH;
__global__ void __launch_bounds__(NTHR, 2) mega_fwd(Args a) {
    extern __shared__ __attribute__((aligned(16))) unsigned char lds_raw[];
    LAS unsigned char* lds = (LAS unsigned char*)lds_raw;
    cg::grid_group grid = cg::this_grid();
    int tid = threadIdx.x, lane = tid & 63, G = gridDim.x; const int wave = __builtin_amdgcn_readfirstlane(tid >> 6);
    unsigned char* ws = a.ws; unsigned char* outb = (unsigned char*)a.out;
    bf16* XB = (bf16*)(ws + WS_XB); bf16* HZ = (bf16*)(ws + WS_HZ); bf16* Y = (bf16*)(ws + WS_Y);
    float* SS0 = (float*)(ws + WS_SS0); float* SS1 = (float*)(ws + WS_SS1); const float* CS = (const float*)(ws + WS_CS);
    const int lo = a.ph_lo, hi = a.ph_hi;
    volatile LAS unsigned* bst = (volatile LAS unsigned*)(lds + LDS_BYTES - 64);
    if (tid < 2) bst[tid] = 0u;
    if (blockIdx.x == 0) for (int i = tid; i < 4096; i += NTHR) __hip_atomic_store((unsigned*)a.ws + i, 0u, RLX_AGENT);
    __syncthreads();
#define FRESH() do { asm volatile("" : "+s"(ws)); asm volatile("" : "+s"(outb)); asm volatile("" : "+s"(G)); asm volatile("" : "+v"(tid)); lane = tid & 63; XB = (bf16*)(ws + WS_XB); HZ = (bf16*)(ws + WS_HZ); Y = (bf16*)(ws + WS_Y); SS0 = (float*)(ws + WS_SS0); SS1 = (float*)(ws + WS_SS1); CS = (const float*)(ws + WS_CS); } while (0)
#ifndef PH_MASK
#define PH_MASK 0x1FFFu
#endif
#define EN(j) ((PH_MASK >> (j)) & 1u)
#ifndef REP_MASK
#define REP_MASK 0u
#endif
#define NREP(j) (1 + (int)((REP_MASK >> (j)) & 1u))
#define IN(k) (lo <= (k) && (k) < hi)
#define SEAM(k) do { if (IN(k) && IN((k) + 1)) xcd_barrier_fn((unsigned*)a.ws, (volatile LAS unsigned*)(lds + LDS_BYTES - 64)); } while (0)
    if (EN(11) && IN(0)) { _Pragma("unroll 1") for (int rep = 0; rep < NREP(11); ++rep) { phase_prologue(a, lds, tid, lane, wave, G); } } if (IN(0) && IN(1)) { grid.sync(); } (void)xcd_barrier_post((unsigned*)a.ws, bst);
#pragma unroll 1
    for (int L = 0; L < DEPTH; ++L) {
        const int pb = 1 + 11 * L;
#define WL() const bf16* wl = (const bf16*)(ws + WS_W) + (size_t)L * W_LAYER
        if (EN(0) && IN(pb + 0)) { FRESH(); WL(); pg8::Gemm g{(const bf16*)(ws + WS_XB2), wl + W_GU1, M, 2 * FF, D}; pg8::StaticOrder S; S.init(M, 2 * FF, G, (int)blockIdx.x); pg8::EpiGLU E{HZ, FF, SS0};
            _Pragma("unroll 1") for (int rep = 0; rep < NREP(0); ++rep) { pg8::gemm_phase<pg8::EpiGLU, pg8::StaticOrder, true, true>(lds, g, S, E); } } SEAM(pb + 0);
        if (EN(1) && IN(pb + 1)) { FRESH(); WL(); pg8::Gemm g{HZ, wl + W_D1, M, D, FF}; pg8::StaticOrder S; S.init(M, D, G, (int)blockIdx.x); pg8::EpiRes<0> E{(const bf16*)(ws + WS_XB2), XB, SS1, 0.5f, nullptr, nullptr};
            pg8::gemm_phase<pg8::EpiRes<0>, pg8::StaticOrder, true, true>(lds, g, S, E); } SEAM(pb + 1);
        if (EN(2) && IN(pb + 2)) { FRESH(); WL(); pg8::Gemm g{XB, wl + W_IN, M, INC, D}; pg8::StaticOrder S; S.init(M, INC, G, (int)blockIdx.x); pg8::EpiZ E{HZ, SS1, CS};
            _Pragma("unroll 1") for (int rep = 0; rep < NREP(2); ++rep) { pg8::gemm_phase<pg8::EpiZ, pg8::StaticOrder, true, true>(lds, g, S, E); } } SEAM(pb + 2);
        if (EN(3) && IN(pb + 3)) { FRESH(); _Pragma("unroll 1") for (int rep = 0; rep < NREP(3); ++rep) { phase_m1(a, L, lds, tid, G, ws, outb); prep_transposes(a, lds, tid, G, ws, outb); } } SEAM(pb + 3);
        if (EN(4) && IN(pb + 4)) { FRESH(); _Pragma("unroll 1") for (int rep = 0; rep < NREP(4); ++rep) { ret_kv_phase(a, tid, G, ws, outb); moba_gate_phase(a, lds, tid, G, ws, outb); } } SEAM(pb + 4);
        if (EN(5) && IN(pb + 5)) { FRESH(); _Pragma("unroll 1") for (int rep = 0; rep < NREP(5); ++rep) { ret_scan_phase(a, tid, G, ws, outb); moba_past_phase(a, L, lds, tid, G, ws, outb); } } SEAM(pb + 5);
        if (EN(6) && IN(pb + 6)) { FRESH(); _Pragma("unroll 1") for (int rep = 0; rep < NREP(6); ++rep) { ret_out_phase(a, lds, tid, G, ws, outb); moba_own_phase(a, lds, tid, G, ws, outb); } } SEAM(pb + 6);
        if (EN(7) && IN(pb + 7)) { FRESH(); WL(); pg8::Gemm g{Y, wl + W_OUT, M, D, D}; pg8::StaticOrder S; S.init(M, D, G, (int)blockIdx.x); pg8::EpiRes<0> E{XB, XB, SS0, 1.0f, nullptr, nullptr};
            pg8::gemm_phase<pg8::EpiRes<0>, pg8::StaticOrder, true, true>(lds, g, S, E); } SEAM(pb + 7);
        if (EN(8) && IN(pb + 8)) { FRESH(); WL(); pg8::Gemm g{XB, wl + W_GU2, M, 2 * FF, D}; pg8::StaticOrder S; S.init(M, 2 * FF, G, (int)blockIdx.x); pg8::EpiGLU E{HZ, FF, SS0};
            _Pragma("unroll 1") for (int rep = 0; rep < NREP(0); ++rep) { pg8::gemm_phase<pg8::EpiGLU, pg8::StaticOrder, true, true>(lds, g, S, E); } }
        if (EN(8) && IN(pb + 8)) { FRESH(); WL(); pg8::Gemm g{(const bf16*)(ws + WS_PB) + (size_t)L * M * PLE, wl + W_PP, M, D, PLE}; pg8::StaticOrder S; S.init(M, D, G, (int)blockIdx.x); pg8::EpiPlain E{Y, D};
            _Pragma("unroll 1") for (int rep = 0; rep < NREP(8); ++rep) { pg8::gemm_phase<pg8::EpiPlain, pg8::StaticOrder, true, true>(lds, g, S, E); } } SEAM(pb + 8);
        if (EN(9) && IN(pb + 9)) { FRESH(); WL(); pg8::Gemm g{HZ, wl + W_D2, M, D, FF}; pg8::StaticOrder S; S.init(M, D, G, (int)blockIdx.x); pg8::EpiRes<0> E{XB, XB, SS1, 0.5f, nullptr, nullptr};
            pg8::gemm_phase<pg8::EpiRes<0>, pg8::StaticOrder, true, true>(lds, g, S, E); } SEAM(pb + 9);
        if (EN(10) && IN(pb + 10)) { FRESH(); WL(); pg8::Gemm g{XB, wl + W_PG, M, D, D}; pg8::StaticOrder S; S.init(M, D, G, (int)blockIdx.x); pg8::EpiRes<1> E{XB, (bf16*)(ws + WS_XB2), SS0, 1.0f, SS1, Y};
            pg8::gemm_phase<pg8::EpiRes<1>, pg8::StaticOrder, true, true>(lds, g, S, E); } SEAM(pb + 10);
    }
    if (EN(12) && IN(N_PHASES - 1)) phase_final(a, lane, wave, G);
#undef IN
#undef SEAM
}

extern "C" void kernel_launch(void* const* d_in, const int* in_sizes, int n_in, void* d_out, int out_size, void* d_ws, size_t ws_size, hipStream_t stream) {
    static int grid = 0;
    if (grid == 0) {
        if (n_in != 19 || out_size != M * D || ws_size < WS_END) { fprintf(stderr, "kernel_launch: unexpected shapes: n_in %d out %d ws %zu (need %zu)\n", n_in, out_size, ws_size, (size_t)WS_END); grid = -1; return; }
        int dev = 0, cus = 0, per_cu = 0;
        if (hipGetDevice(&dev) != hipSuccess || hipDeviceGetAttribute(&cus, hipDeviceAttributeMultiprocessorCount, dev) != hipSuccess) { grid = -1; return; }
        if (hipFuncSetAttribute((const void*)mega_fwd, hipFuncAttributeMaxDynamicSharedMemorySize, LDS_BYTES) != hipSuccess) { fprintf(stderr, "kernel_launch: hipFuncSetAttribute failed\n"); grid = -1; return; }
        if (hipOccupancyMaxActiveBlocksPerMultiprocessor(&per_cu, (const void*)mega_fwd, NTHR, LDS_BYTES) != hipSuccess || per_cu < 1) { fprintf(stderr, "kernel_launch: occupancy query says %d\n", per_cu); per_cu = 1; }
        (void)hipGetLastError();
        grid = cus;
    }
    if (grid < 0) return;
    Args a{};
    for (int i = 0; i < 19; ++i) a.in[i] = (const float*)d_in[i];
    a.out = (float*)d_out; a.ws = (unsigned char*)d_ws;
    for (int i = 0; i < 32; ++i) a.theta[i] = 1.0 / pow(10000.0, (double)i / 31.0);
    for (int h = 0; h < 4; ++h) a.lg2g[h] = (float)log2(1.0 - pow(2.0, -5.0 - (double)h));
    a.ph_lo = 0; a.ph_hi = N_PHASES;
    void* args[] = {&a};
    hipError_t e = hipLaunchCooperativeKernel((const void*)mega_fwd, dim3(grid), dim3(NTHR), args, LDS_BYTES, stream);
    if (e != hipSuccess) fprintf(stderr, "kernel_launch: cooperative launch failed: %s (grid %d)\n", hipGetErrorString(e), grid);
}
```

```cpp
#include <hip/hip_runtime.h>
#include <hip/hip_cooperative_groups.h>
#include <cstdio>
#include <cstdint>
#include <cmath>
namespace cg = cooperative_groups;
namespace pg8 {
#define PG8_LAS __attribute__((address_space(3)))
typedef unsigned short bf16_t;
typedef short bf16x8 __attribute__((ext_vector_type(8)));
typedef float f32x4 __attribute__((ext_vector_type(4)));
typedef unsigned u32x4 __attribute__((ext_vector_type(4)));
constexpr int BM = 256, BK = 64, HALF = 128, HTB = HALF * BK * 2  , STAGE_BYTES = 8 * HTB, NXCD = 8, WGM = 8;

__host__ __device__ __forceinline__ int lds_byte(int r, int c) { const int st = (r >> 4) * 2 + (c >> 5), rr = r & 15, cc = c & 31, ob = rr * 64 + cc * 2; return st * 1024 + (ob ^ (((ob >> 9) & 1) << 5)); }
__host__ __device__ __forceinline__ void stage_rc(int b, int& R, int& C) { const int st = b / 1024, sb = b % 1024, swz = sb ^ (((sb >> 9) & 1) << 5); R = (st >> 1) * 16 + swz / 64; C = (st & 1) * 32 + (swz % 64) / 2; }
__host__ __device__ __forceinline__ int perm32(int rho) { const int n = rho >> 4, i = rho & 15; return 8 * (i >> 2) + 4 * n + (i & 3); }

struct Unit { int pm, pn; };
struct Gemm { const bf16_t* A; const bf16_t* Bt; int M, N, K; };

struct StaticOrder {
    int nM, nN, nwg, G, c;
    __host__ __device__ void init(int M, int N, int G_, int c_) { nM = M / BM; nN = N / BM; nwg = nM * nN; G = G_; c = c_; }
    __host__ __device__ bool next(int i, Unit& u) const {
        const long L = (long)i * G + c; if (L >= nwg) return false;
        int wgid = (int)L; { const int q = nwg / NXCD, r = nwg % NXCD, xcd = wgid % NXCD, off = wgid / NXCD; wgid = (xcd < r ? xcd * (q + 1) : r * (q + 1) + (xcd - r) * q) + off; }
        const int nig = WGM * nN, gid = wgid / nig, fm = gid * WGM, gsz = (nM - fm) < WGM ? (nM - fm) : WGM;
        u.pm = fm + ((wgid % nig) % gsz); u.pn = (wgid % nig) / gsz; return true;
    }
    __device__ __forceinline__ void a_ready(const Unit&) const {}
    __device__ __forceinline__ void done(const Unit&) const {}
};

__device__ __forceinline__ unsigned cvt_pk_bf16(float lo, float hi) { unsigned r; asm volatile("v_cvt_pk_bf16_f32 %0, %1, %2" : "=v"(r) : "v"(lo), "v"(hi)); return r; }
__device__ __forceinline__ float row_rstd(const float* ssp, int row, int fq) {
    const f32x4 v = *(const f32x4*)(ssp + (size_t)row * 16 + fq * 4);
    float s = (v[0] + v[1]) + (v[2] + v[3]);
    s += __shfl_xor(s, 16); s += __shfl_xor(s, 32);
    return __builtin_amdgcn_rsqf(s * (1.0f / 1024.0f) + 1e-6f);
}
__device__ __forceinline__ float silu_f(float g) { return g * __builtin_amdgcn_rcpf(1.0f + __builtin_amdgcn_exp2f(-1.44269504089f * g)); }
__device__ __forceinline__ float sigm_f(float g) { return __builtin_amdgcn_rcpf(1.0f + __builtin_amdgcn_exp2f(-1.44269504089f * g)); }

struct EpiGLU {
    static constexpr bool PERM = true, AFTER_DRAIN = false;
    bf16_t* H; int ldh; const float* ssp;
    __device__ __forceinline__ void operator()(const f32x4 (&acc)[2][2][4][2], const Unit& u, int wr, int wc, int fr, int fq) const {
        const int row0 = u.pm * BM + wr * 64 + fr, col0 = u.pn * HALF + wc * 32 + 8 * fq;
#pragma unroll
        for (int ai = 0; ai < 2; ++ai)
#pragma unroll
            for (int m = 0; m < 4; ++m) {
                const int row = row0 + ai * HALF + m * 16; const float r = row_rstd(ssp, row, fq);
                const float rc = r * -1.44269504089f, r2 = r * r;
                const f32x4 ga = acc[ai][0][m][0], gb = acc[ai][0][m][1];
                const f32x4 pa = (ga * acc[ai][1][m][0]) * r2, pb = (gb * acc[ai][1][m][1]) * r2;
                const f32x4 ta = ga * rc, tb = gb * rc;
                f32x4 ha, hb;
#pragma unroll
                for (int k = 0; k < 4; ++k) { ha[k] = pa[k] * __builtin_amdgcn_rcpf(1.0f + __builtin_amdgcn_exp2f(ta[k])); hb[k] = pb[k] * __builtin_amdgcn_rcpf(1.0f + __builtin_amdgcn_exp2f(tb[k])); }
                u32x4 w; w.x = cvt_pk_bf16(ha[0], ha[1]); w.y = cvt_pk_bf16(ha[2], ha[3]); w.z = cvt_pk_bf16(hb[0], hb[1]); w.w = cvt_pk_bf16(hb[2], hb[3]);
                *(u32x4*)(H + (size_t)row * ldh + col0) = w;
            }
    }
};
__device__ __forceinline__ void unpack8(const u32x4 w, f32x4& a, f32x4& b) {
    a[0] = __uint_as_float(w.x << 16); a[1] = __uint_as_float(w.x & 0xffff0000u); a[2] = __uint_as_float(w.y << 16); a[3] = __uint_as_float(w.y & 0xffff0000u);
    b[0] = __uint_as_float(w.z << 16); b[1] = __uint_as_float(w.z & 0xffff0000u); b[2] = __uint_as_float(w.w << 16); b[3] = __uint_as_float(w.w & 0xffff0000u);
}
template <int MODE> struct EpiRes {
    static constexpr bool PERM = true, AFTER_DRAIN = false;
    const bf16_t* xin; bf16_t* xout; float* ssp_out; float alpha; const float* ssp_in; const bf16_t* PP;
    __device__ __forceinline__ void operator()(const f32x4 (&acc)[2][2][4][2], const Unit& u, int wr, int wc, int fr, int fq) const {
        const int row0 = u.pm * BM + wr * 64 + fr, col0 = u.pn * BM + wc * 32 + 8 * fq;
        constexpr int MB = (MODE == 1) ? 2 : 4;
#pragma unroll
        for (int ai = 0; ai < 2; ++ai)
#pragma unroll
        for (int mb = 0; mb < 4; mb += MB) {
            u32x4 xv[MB][2], pv[MB][2]; float r[MB];
#pragma unroll
            for (int mm = 0; mm < MB; ++mm) {
                const int m = mb + mm; const size_t off = (size_t)(row0 + ai * HALF + m * 16) * 1024 + col0;
                xv[mm][0] = *(const u32x4*)(xin + off); xv[mm][1] = *(const u32x4*)(xin + off + HALF);
                if (MODE == 1) { pv[mm][0] = *(const u32x4*)(PP + off); pv[mm][1] = *(const u32x4*)(PP + off + HALF); r[mm] = row_rstd(ssp_in, row0 + ai * HALF + m * 16, fq); }
            }
#pragma unroll
            for (int mm = 0; mm < MB; ++mm) {
                const int m = mb + mm; const int row = row0 + ai * HALF + m * 16; float ss = 0.f;
#pragma unroll
                for (int bj = 0; bj < 2; ++bj) {
                    f32x4 a, b, d0, d1; unpack8(xv[mm][bj], a, b);
                    if (MODE == 0) { d0 = acc[ai][bj][m][0] * alpha; d1 = acc[ai][bj][m][1] * alpha; }
                    else {
                        f32x4 p0, p1; unpack8(pv[mm][bj], p0, p1);
                        const f32x4 t0 = acc[ai][bj][m][0] * r[mm], t1 = acc[ai][bj][m][1] * r[mm];
#pragma unroll
                        for (int k = 0; k < 4; ++k) { d0[k] = sigm_f(t0[k]) * p0[k]; d1[k] = sigm_f(t1[k]) * p1[k]; }
                    }
                    a = a + d0; b = b + d1;
                    u32x4 w; w.x = cvt_pk_bf16(a[0], a[1]); w.y = cvt_pk_bf16(a[2], a[3]); w.z = cvt_pk_bf16(b[0], b[1]); w.w = cvt_pk_bf16(b[2], b[3]);
                    *(u32x4*)(xout + (size_t)row * 1024 + col0 + bj * HALF) = w;
                    unpack8(w, a, b);
                    ss += ((a[0] * a[0] + a[1] * a[1]) + (a[2] * a[2] + a[3] * a[3])) + ((b[0] * b[0] + b[1] * b[1]) + (b[2] * b[2] + b[3] * b[3]));
                }
                ss += __shfl_xor(ss, 16); ss += __shfl_xor(ss, 32);
                if (fq == 0) ssp_out[(size_t)row * 16 + u.pn * 4 + wc] = ss;
            }
        }
    }
};
struct EpiZ {
    static constexpr bool PERM = true, AFTER_DRAIN = false;
    bf16_t* Z; const float* ssp; const float* cs;
    __device__ __forceinline__ void operator()(const f32x4 (&acc)[2][2][4][2], const Unit& u, int wr, int wc, int fr, int fq) const {
        const int row0 = u.pm * BM + wr * 64 + fr, col0 = u.pn * BM + wc * 32 + 8 * fq;
        const bool rot = u.pn < 2; const float sc = (u.pn == 1 || u.pn == 7) ? 0.125f : 1.0f;
#pragma unroll
        for (int ai = 0; ai < 2; ++ai)
#pragma unroll
            for (int m = 0; m < 4; ++m) {
                const int row = row0 + ai * HALF + m * 16; const float r = row_rstd(ssp, row, fq) * sc;
#pragma unroll
                for (int bj = 0; bj < 2; ++bj) {
                    const int col = col0 + bj * HALF;
                    f32x4 a = acc[ai][bj][m][0] * r, b = acc[ai][bj][m][1] * r;
                    if (rot) {
                        const float* t = cs + ((size_t)(row & 8191) * 32 + ((col & 63) >> 1)) * 2;
                        const f32x4 t0 = *(const f32x4*)t, t1 = *(const f32x4*)(t + 4);
                        f32x4 a2, b2;
                        a2[0] = a[0] * t0[0] - a[1] * t0[1]; a2[1] = a[1] * t0[0] + a[0] * t0[1];
                        a2[2] = a[2] * t0[2] - a[3] * t0[3]; a2[3] = a[3] * t0[2] + a[2] * t0[3];
                        b2[0] = b[0] * t1[0] - b[1] * t1[1]; b2[1] = b[1] * t1[0] + b[0] * t1[1];
                        b2[2] = b[2] * t1[2] - b[3] * t1[3]; b2[3] = b[3] * t1[2] + b[2] * t1[3];
                        a = a2; b = b2;
                    }
                    u32x4 w; w.x = cvt_pk_bf16(a[0], a[1]); w.y = cvt_pk_bf16(a[2], a[3]); w.z = cvt_pk_bf16(b[0], b[1]); w.w = cvt_pk_bf16(b[2], b[3]);
                    *(u32x4*)(Z + (size_t)row * 2560 + col) = w;
                }
            }
    }
};
struct EpiPlain {
    static constexpr bool PERM = true, AFTER_DRAIN = false;
    bf16_t* O; int ldc;
    __device__ __forceinline__ void operator()(const f32x4 (&acc)[2][2][4][2], const Unit& u, int wr, int wc, int fr, int fq) const {
        const int row0 = u.pm * BM + wr * 64 + fr, col0 = u.pn * BM + wc * 32 + 8 * fq;
#pragma unroll
        for (int ai = 0; ai < 2; ++ai)
#pragma unroll
            for (int m = 0; m < 4; ++m)
#pragma unroll
                for (int bj = 0; bj < 2; ++bj) {
                    const f32x4 a = acc[ai][bj][m][0], b = acc[ai][bj][m][1];
                    u32x4 w; w.x = cvt_pk_bf16(a[0], a[1]); w.y = cvt_pk_bf16(a[2], a[3]); w.z = cvt_pk_bf16(b[0], b[1]); w.w = cvt_pk_bf16(b[2], b[3]);
                    *(u32x4*)(O + (size_t)(row0 + ai * HALF + m * 16) * ldc + col0 + bj * HALF) = w;
                }
    }
};

template <class Epi, class Sched, bool ALIGN_EPI = false, bool SP2 = false>
__device__ __forceinline__ void gemm_phase(PG8_LAS unsigned char* lds, const Gemm g, const Sched& S, const Epi& E) {
    int tid_l = threadIdx.x; asm volatile("" : "+v"(tid_l));
    const int tid = tid_l, wid = __builtin_amdgcn_readfirstlane(tid >> 6), lane = tid & 63, wr = wid >> 2, wc = wid & 3, fr = lane & 15, fq = lane >> 4;
    const int K = g.K, nt = K / BK;
    unsigned voffA[2], voffB[2];
#pragma unroll
    for (int i = 0; i < 2; ++i) { int R, C; stage_rc(tid * 16 + i * 8192, R, C); const int Rb = Epi::PERM ? ((R & ~31) + perm32(R & 31)) : R;
        voffA[i] = (unsigned)(R * K + C) * 2u; voffB[i] = (unsigned)(Rb * K + C) * 2u; }
    const size_t kstep = (size_t)(BK * 2);
    const size_t hstep = (size_t)HALF * K * 2;
    const size_t tstep = 2 * hstep;
    const unsigned ldsw = (unsigned)wid * 1024u;
    const int aoff = lds_byte(wr * 64 + fr, fq * 8), boff = lds_byte(wc * 32 + fr, fq * 8);
#define PG8_SA(b, h) (((b) * 2 + (h)) * HTB)
#define PG8_SB(b, h) ((4 + (b) * 2 + (h)) * HTB)
#define PG8_STAGE(bufoff, gbase, voff) do { _Pragma("unroll") for (int _i = 0; _i < 2; ++_i) \
        __builtin_amdgcn_global_load_lds((const unsigned*)((const char*)(gbase) + (voff)[_i]), (PG8_LAS unsigned*)(lds + (bufoff) + ldsw + _i * 8192), 16, 0, 0); } while (0)
#define PG8_LDA(dst, b, h) do { _Pragma("unroll") for (int m = 0; m < 4; ++m) _Pragma("unroll") for (int k = 0; k < 2; ++k) dst[m][k] = *(const PG8_LAS bf16x8*)(lds + PG8_SA(b, h) + aoff + m * 2048 + k * 1024); } while (0)
#define PG8_LDB(dst, b, h) do { _Pragma("unroll") for (int n = 0; n < 2; ++n) _Pragma("unroll") for (int k = 0; k < 2; ++k) dst[n][k] = *(const PG8_LAS bf16x8*)(lds + PG8_SB(b, h) + boff + n * 2048 + k * 1024); } while (0)
#define PG8_MMA(ai, bj, At, Bt) do { __builtin_amdgcn_s_setprio(1); _Pragma("unroll") for (int m = 0; m < 4; ++m) _Pragma("unroll") for (int n = 0; n < 2; ++n) _Pragma("unroll") for (int k = 0; k < 2; ++k) \
        acc[ai][bj][m][n] = __builtin_amdgcn_mfma_f32_16x16x32_bf16(Bt[n][k], At[m][k], acc[ai][bj][m][n], 0, 0, 0); __builtin_amdgcn_s_setprio(0); } while (0)
#define PG8_WAIT_V(n) asm volatile("s_waitcnt vmcnt(" #n ")" ::: "memory")
#define PG8_WAIT_L(n) asm volatile("s_waitcnt lgkmcnt(" #n ")" ::: "memory")
#define PG8_BAR __builtin_amdgcn_s_barrier()
#define PG8_SCHED __builtin_amdgcn_sched_barrier(0)
    Unit cur, nxt; int ui = 0;
    if (!S.next(0, cur)) return;
    f32x4 acc[2][2][4][2];
#pragma unroll
    for (int a = 0; a < 2; ++a)
#pragma unroll
        for (int b = 0; b < 2; ++b)
#pragma unroll
            for (int m = 0; m < 4; ++m)
#pragma unroll
                for (int n = 0; n < 2; ++n) acc[a][b][m][n] = (f32x4){0.f, 0.f, 0.f, 0.f};
    bf16x8 At[4][2], B0[2][2], B1[2][2];
    const char* cA = (const char*)g.A + (size_t)cur.pm * tstep; const char* cB = (const char*)g.Bt + (size_t)cur.pn * tstep;
    S.a_ready(cur);
    if constexpr (SP2) {
        PG8_STAGE(PG8_SB(0, 0), cB, voffB); PG8_STAGE(PG8_SB(0, 1), cB + hstep, voffB); PG8_STAGE(PG8_SA(0, 0), cA, voffA); PG8_STAGE(PG8_SA(0, 1), cA + hstep, voffA);
        if (wr == 1) PG8_BAR;
        PG8_WAIT_V(2); PG8_BAR;
        PG8_STAGE(PG8_SB(1, 0), cB + kstep, voffB); PG8_STAGE(PG8_SA(1, 0), cA + kstep, voffA); PG8_STAGE(PG8_SB(1, 1), cB + hstep + kstep, voffB);
        PG8_WAIT_V(6); PG8_BAR;
    } else {
        PG8_STAGE(PG8_SB(0, 0), cB, voffB); PG8_STAGE(PG8_SA(0, 0), cA, voffA); PG8_STAGE(PG8_SB(0, 1), cB + hstep, voffB); PG8_STAGE(PG8_SA(0, 1), cA + hstep, voffA);
        if (wr == 1) PG8_BAR;
        PG8_WAIT_V(4); PG8_BAR;
        PG8_STAGE(PG8_SB(1, 0), cB + kstep, voffB); PG8_STAGE(PG8_SA(1, 0), cA + kstep, voffA); PG8_STAGE(PG8_SB(1, 1), cB + hstep + kstep, voffB);
        PG8_WAIT_V(6); PG8_BAR;
    }
    for (;;) {
        const bool has_next = S.next(ui + 1, nxt);
        const char* nA = has_next ? (const char*)g.A + (size_t)nxt.pm * tstep : cA; const char* nB = has_next ? (const char*)g.Bt + (size_t)nxt.pn * tstep : cB;
#pragma unroll 1
        for (int t = 0; t < nt; t += 2) {
            const bool last = (t == nt - 2);
            const char* a1 = cA + (size_t)(t + 1) * kstep;
            const char* a2 = last ? nA : cA + (size_t)(t + 2) * kstep; const char* b2 = last ? nB : cB + (size_t)(t + 2) * kstep;
            const char* a3 = a2 + kstep; const char* b3 = b2 + kstep;
            if (last && has_next) S.a_ready(nxt);
            if constexpr (SP2) {
            PG8_LDB(B0, 0, 0); PG8_LDB(B1, 0, 1); PG8_SCHED; PG8_LDA(At, 0, 0); PG8_STAGE(PG8_SA(1, 1), a1 + hstep, voffA);
            PG8_WAIT_V(8); PG8_WAIT_L(0); PG8_BAR; PG8_MMA(0, 0, At, B0); PG8_MMA(0, 1, At, B1); PG8_BAR; PG8_SCHED;
            PG8_LDA(At, 0, 1); PG8_STAGE(PG8_SB(0, 0), b2, voffB); PG8_STAGE(PG8_SB(0, 1), b2 + hstep, voffB); PG8_STAGE(PG8_SA(0, 0), a2, voffA);
            PG8_WAIT_V(8); PG8_WAIT_L(0); PG8_BAR; PG8_MMA(1, 0, At, B0); PG8_MMA(1, 1, At, B1); PG8_BAR; PG8_SCHED;
            PG8_LDB(B0, 1, 0); PG8_LDB(B1, 1, 1); PG8_SCHED; PG8_LDA(At, 1, 0); PG8_STAGE(PG8_SA(0, 1), a2 + hstep, voffA);
            PG8_WAIT_V(8); PG8_WAIT_L(0); PG8_BAR; PG8_MMA(0, 0, At, B0); PG8_MMA(0, 1, At, B1); PG8_BAR; PG8_SCHED;
            PG8_LDA(At, 1, 1); PG8_STAGE(PG8_SB(1, 0), b3, voffB); PG8_STAGE(PG8_SB(1, 1), b3 + hstep, voffB); PG8_STAGE(PG8_SA(1, 0), a3, voffA);
            PG8_WAIT_V(8); PG8_WAIT_L(0); PG8_BAR; PG8_MMA(1, 0, At, B0); PG8_MMA(1, 1, At, B1); PG8_BAR; PG8_SCHED;
            } else {
            PG8_LDB(B0, 0, 0); PG8_SCHED; PG8_LDA(At, 0, 0); PG8_STAGE(PG8_SA(1, 1), a1 + hstep, voffA);
            PG8_WAIT_L(8); PG8_BAR; PG8_WAIT_L(0); PG8_MMA(0, 0, At, B0); PG8_BAR; PG8_SCHED;
            PG8_LDB(B1, 0, 1); PG8_STAGE(PG8_SB(0, 0), b2, voffB);
            PG8_BAR; PG8_WAIT_L(0); PG8_MMA(0, 1, At, B1); PG8_BAR;
            PG8_LDA(At, 0, 1); PG8_STAGE(PG8_SA(0, 0), a2, voffA);
            PG8_BAR; PG8_WAIT_L(0); PG8_MMA(1, 0, At, B0); PG8_BAR; PG8_SCHED;
            PG8_STAGE(PG8_SB(0, 1), b2 + hstep, voffB);
            PG8_WAIT_V(6); PG8_BAR; PG8_MMA(1, 1, At, B1); PG8_BAR;
            PG8_LDB(B0, 1, 0); PG8_SCHED; PG8_LDA(At, 1, 0); PG8_STAGE(PG8_SA(0, 1), a2 + hstep, voffA);
            PG8_WAIT_L(8); PG8_BAR; PG8_WAIT_L(0); PG8_MMA(0, 0, At, B0); PG8_BAR; PG8_SCHED;
            PG8_LDB(B1, 1, 1); PG8_STAGE(PG8_SB(1, 0), b3, voffB);
            PG8_BAR; PG8_WAIT_L(0); PG8_MMA(0, 1, At, B1); PG8_BAR;
            PG8_LDA(At, 1, 1); PG8_STAGE(PG8_SA(1, 0), a3, voffA);
            PG8_BAR; PG8_WAIT_L(0); PG8_MMA(1, 0, At, B0); PG8_BAR; PG8_SCHED;
            PG8_STAGE(PG8_SB(1, 1), b3 + hstep, voffB);
            PG8_WAIT_V(6); PG8_BAR; PG8_MMA(1, 1, At, B1); PG8_BAR;
            }
        }
        if constexpr (ALIGN_EPI) { if (wr == 0) PG8_BAR; }
        if constexpr (!Epi::AFTER_DRAIN) { E(acc, cur, wr, wc, fr, fq); S.done(cur); }
        if (!has_next) break;
#pragma unroll
        for (int a = 0; a < 2; ++a)
#pragma unroll
            for (int b = 0; b < 2; ++b)
#pragma unroll
                for (int m = 0; m < 4; ++m)
#pragma unroll
                    for (int n = 0; n < 2; ++n) acc[a][b][m][n] = (f32x4){0.f, 0.f, 0.f, 0.f};
        cur = nxt; cA = nA; cB = nB; ++ui;
        if constexpr (ALIGN_EPI) { if (wr == 1) PG8_BAR; }
    }
    PG8_WAIT_V(0);
    if constexpr (!ALIGN_EPI) { if (wr == 0) PG8_BAR; }
    PG8_BAR;
    if constexpr (Epi::AFTER_DRAIN) { E.fused(acc, cur, wr, wc, fr, fq, lds, wid, lane); S.done(cur); }
#undef PG8_SA
#undef PG8_SB
#undef PG8_STAGE
#undef PG8_LDA
#undef PG8_LDB
#undef PG8_MMA
#undef PG8_WAIT_V
#undef PG8_WAIT_L
#undef PG8_BAR
#undef PG8_SCHED
}
}

#define LAS __attribute__((address_space(3)))
typedef unsigned short bf16;
typedef float f32x4 __attribute__((ext_vector_type(4)));
typedef unsigned u32x4 __attribute__((ext_vector_type(4)));
typedef unsigned u32x2 __attribute__((ext_vector_type(2)));

constexpr int NWAVES = 8, NTHR = 512;
constexpr int BATCH = 8, SEQ = 8192, D = 1024, FF = 2816, INC = 2560, PLE = 256, DEPTH = 2;
constexpr int M = BATCH * SEQ;
constexpr int ZQ = 0, ZK = 256, ZV = 512, ZG = 1024, ZP = 1536, ZMQ = 1792, ZMK = 2048, ZMV = 2304;
constexpr size_t MiB = 1u << 20;
constexpr size_t WS_CS = 1 * MiB, WS_SS0 = 3 * MiB, WS_SS1 = 7 * MiB, WS_KMEAN = 11 * MiB, WS_W = 12 * MiB;
constexpr size_t W_GU1 = 0, W_D1 = W_GU1 + (size_t)2 * FF * D, W_IN = W_D1 + (size_t)D * FF, W_OUT = W_IN + (size_t)INC * D, W_GU2 = W_OUT + (size_t)D * D,
                 W_D2 = W_GU2 + (size_t)2 * FF * D, W_PG = W_D2 + (size_t)D * FF, W_PP = W_PG + (size_t)D * D, W_LAYER = W_PP + (size_t)D * PLE;
static_assert(WS_W + 2 * W_LAYER * 2 <= 100 * MiB, "weights");
constexpr size_t WS_XB = 100 * MiB, WS_HZ = 228 * MiB, WS_Y = 580 * MiB, WS_PB = 708 * MiB, WS_KV = 772 * MiB, WS_RS = 804 * MiB, WS_XB2 = 836 * MiB, WS_END = 964 * MiB;
static_assert((size_t)M * FF * 2 == 352 * MiB && (size_t)M * D * 2 == 128 * MiB, "sizes");
constexpr int LDS_BYTES = 147456;

__device__ __forceinline__ unsigned f2bf(float f) { unsigned u = __builtin_bit_cast(unsigned, f); return (u + 0x7fffu + ((u >> 16) & 1u)) >> 16; }
__device__ __forceinline__ unsigned pk2(float lo, float hi) { return pg8::cvt_pk_bf16(lo, hi); }
__device__ __forceinline__ float bflo(unsigned w) { return __uint_as_float(w << 16); }
__device__ __forceinline__ float bfhi(unsigned w) { return __uint_as_float(w & 0xffff0000u); }
__device__ __forceinline__ float bf1(bf16 h) { return __uint_as_float((unsigned)h << 16); }
__device__ __forceinline__ float wave_sum(float v) {
#pragma unroll
    for (int o = 1; o < 64; o <<= 1) v += __shfl_xor(v, o);
    return v;
}
#define LDS_WAIT() asm volatile("s_waitcnt lgkmcnt(0)" ::: "memory")

struct Args {
    const float* in[19]; float* out; unsigned char* ws;
    double theta[32]; float lg2g[4];
    int ph_lo, ph_hi;
};

__device__ __forceinline__ void transpose_item(const float* W, int K, int N, const float* gain, bf16* WT, int k0, int n0, int row_off, LAS float* scr, int lane) {
#pragma unroll 8
    for (int i = 0; i < 32; ++i) { const int kk = 2 * i + (lane >> 5); float v = W[(size_t)(k0 + kk) * N + n0 + (lane & 31)]; if (gain) v *= gain[k0 + kk]; scr[kk * 33 + (lane & 31)] = v; }
    LDS_WAIT(); asm volatile("" ::: "memory");
    const int c = lane & 7;
#pragma unroll
    for (int j = 0; j < 4; ++j) { const int n = (lane >> 3) + 8 * j; const LAS float* s = scr + (8 * c) * 33 + n;
        u32x4 o; o.x = pk2(s[0 * 33], s[1 * 33]); o.y = pk2(s[2 * 33], s[3 * 33]); o.z = pk2(s[4 * 33], s[5 * 33]); o.w = pk2(s[6 * 33], s[7 * 33]);
        *(u32x4*)(WT + (size_t)(row_off + n) * K + k0 + 8 * c) = o; }
    LDS_WAIT(); asm volatile("" ::: "memory");
}
__device__ __forceinline__ void tr_plain(const float* W, int K, int N, const float* gain, bf16* WT, int it, LAS float* scr, int lane) {
    const int nblk = N / 32, kb = it / nblk, nb = it % nblk; transpose_item(W, K, N, gain, WT, 64 * kb, 32 * nb, 32 * nb, scr, lane);
}
__device__ __forceinline__ void tr_glu(const float* W, const float* gain, bf16* WT, int up, int it, LAS float* scr, int lane) {
    const int nblk = FF / 32, kb = it / nblk, nb = it % nblk, n0 = 32 * nb; transpose_item(W, D, FF, gain, WT, 64 * kb, n0, (n0 >> 7) * 256 + (n0 & 127) + up * 128, scr, lane);
}

__device__ __forceinline__ void sincos_d(double x, float& c, float& s) {
    const double TWO_PI = 6.283185307179586476925286766559;
    const double n = rint(x / TWO_PI); const double r = x - n * TWO_PI, r2 = r * r;
    double ss = 1.0, cc = 1.0;
#pragma unroll
    for (int k = 15; k >= 1; --k) { ss = 1.0 - r2 * (1.0 / (double)((2 * k) * (2 * k + 1))) * ss; cc = 1.0 - r2 * (1.0 / (double)((2 * k - 1) * (2 * k))) * cc; }
    s = (float)(r * ss); c = (float)cc;
}

__device__ __forceinline__ void phase_prologue(const Args& a, LAS unsigned char* lds, int tid, int lane, int wave, int G) {
    unsigned char* ws = a.ws;
    LAS float* scr = (LAS float*)(lds + wave * 16384);
    const int gw = blockIdx.x * NWAVES + wave, NGW = G * NWAVES;
    constexpr int I_GU = (D / 64) * (FF / 32), I_DN = (FF / 64) * (D / 32), I_IN = (D / 64) * (INC / 32), I_SQ = (D / 64) * (D / 32), I_PP = (PLE / 64) * (D / 32);
    constexpr int I_LAYER = 4 * I_GU + 2 * I_DN + I_IN + 2 * I_SQ + I_PP;
    for (int it = gw; it < DEPTH * I_LAYER; it += NGW) {
        const int L = it / I_LAYER; int r = it % I_LAYER;
        bf16* wl = (bf16*)(ws + WS_W) + (size_t)L * W_LAYER;
        const float* n1 = a.in[2] + L * D; const float* nm = a.in[6] + L * D; const float* n2 = a.in[11] + L * D; const float* np = a.in[15] + L * D;
        if (r < I_GU) { tr_glu(a.in[3] + (size_t)L * D * FF, n1, wl + W_GU1, 0, r, scr, lane); continue; } r -= I_GU;
        if (r < I_GU) { tr_glu(a.in[4] + (size_t)L * D * FF, n1, wl + W_GU1, 1, r, scr, lane); continue; } r -= I_GU;
        if (r < I_DN) { tr_plain(a.in[5] + (size_t)L * FF * D, FF, D, nullptr, wl + W_D1, r, scr, lane); continue; } r -= I_DN;
        if (r < I_IN) { tr_plain(a.in[7] + (size_t)L * D * INC, D, INC, nm, wl + W_IN, r, scr, lane); continue; } r -= I_IN;
        if (r < I_SQ) { tr_plain(a.in[10] + (size_t)L * D * D, D, D, nullptr, wl + W_OUT, r, scr, lane); continue; } r -= I_SQ;
        if (r < I_GU) { tr_glu(a.in[12] + (size_t)L * D * FF, n2, wl + W_GU2, 0, r, scr, lane); continue; } r -= I_GU;
        if (r < I_GU) { tr_glu(a.in[13] + (size_t)L * D * FF, n2, wl + W_GU2, 1, r, scr, lane); continue; } r -= I_GU;
        if (r < I_DN) { tr_plain(a.in[14] + (size_t)L * FF * D, FF, D, nullptr, wl + W_D2, r, scr, lane); continue; } r -= I_DN;
        if (r < I_SQ) { tr_plain(a.in[16] + (size_t)L * D * D, D, D, np, wl + W_PG, r, scr, lane); continue; } r -= I_SQ;
        tr_plain(a.in[17] + (size_t)L * PLE * D, PLE, D, nullptr, wl + W_PP, r, scr, lane);
    }
    {
        const float* x = a.in[0]; bf16* xb = (bf16*)(ws + WS_XB2); float* ss = (float*)(ws + WS_SS0);
        for (int m = gw; m < M; m += NGW) {
            const f32x4* xr = (const f32x4*)(x + (size_t)m * D) + lane; u32x2* brow = (u32x2*)(xb + (size_t)m * D) + lane;
            float s = 0.f;
#pragma unroll
            for (int j = 0; j < 4; ++j) { const f32x4 v = xr[64 * j]; u32x2 w; w.x = pk2(v[0], v[1]); w.y = pk2(v[2], v[3]); brow[64 * j] = w;
                const float r0 = bflo(w.x), r1 = bfhi(w.x), r2 = bflo(w.y), r3 = bfhi(w.y); s += (r0 * r0 + r1 * r1) + (r2 * r2 + r3 * r3); }
            s = wave_sum(s);
            if (lane < 16) ss[(size_t)m * 16 + lane] = (lane == 0) ? s : 0.f;
        }
    }
    {
        const f32x4* p = (const f32x4*)a.in[1]; u32x2* pb = (u32x2*)(ws + WS_PB);
        const size_t n4 = (size_t)DEPTH * M * PLE / 4;
        for (size_t i = (size_t)blockIdx.x * NTHR + tid; i < n4; i += (size_t)G * NTHR) { const f32x4 v = p[i]; u32x2 w; w.x = pk2(v[0], v[1]); w.y = pk2(v[2], v[3]); pb[i] = w; }
    }
    {
        float* cs = (float*)(ws + WS_CS);
        for (int i = blockIdx.x * NTHR + tid; i < SEQ * 32; i += G * NTHR) { const int pos = i >> 5, k = i & 31; float c, s; sincos_d((double)pos * a.theta[k], c, s); cs[2 * i] = c; cs[2 * i + 1] = s; }
    }
}


typedef float f32x16 __attribute__((ext_vector_type(16)));
typedef short bf16x8 __attribute__((ext_vector_type(8)));
#define MFMA32(a, b, c) __builtin_amdgcn_mfma_f32_32x32x16_bf16((a), (b), (c), 0, 0, 0)
constexpr size_t OUT_VTM = 0, OUT_VTR = 32 * MiB, OUT_KTZ = 96 * MiB;
__device__ __forceinline__ int crow(int i, int hh) { return (i & 3) + 8 * (i >> 2) + 4 * hh; }

__device__ __forceinline__ void prep_transposes(const Args& a, LAS unsigned char* lds, int tid, int G, unsigned char* ws_, unsigned char* outb_) {
    unsigned char* ws = ws_; unsigned char* outb = outb_; (void)outb; const bf16* Z = (const bf16*)(ws + WS_HZ);
    LAS unsigned* T = (LAS unsigned*)lds;
    const int lane = tid & 63, w = tid >> 6;
    for (int it = blockIdx.x; it < BATCH * 32 * 5; it += G) {
        const int kind = it % 5, blk = (it / 5) & 31, b = it / 160;
        const int src = kind == 0 ? ZMV : (kind == 1 ? ZV : (kind == 2 ? ZV + 256 : (kind == 3 ? ZK : ZMK)));
        bf16* dst = kind == 0 ? (bf16*)(outb + OUT_VTM) + (size_t)b * 256 * SEQ : (kind == 3 ? (bf16*)(outb + OUT_KTZ) + (size_t)b * 256 * SEQ : (bf16*)(outb + OUT_VTR) + ((size_t)b * 512 + (kind == 2 ? 256 : 0)) * SEQ);
        __syncthreads();
        for (int c = tid; c < 256 * 32; c += NTHR) { const int r = c >> 5, cc = c & 31; const u32x4 v = *(const u32x4*)(Z + ((size_t)b * SEQ + blk * 256 + r) * INC + src + cc * 8);
            LAS unsigned* t = T + r * 129 + cc * 4; t[0] = v.x; t[1] = v.y; t[2] = v.z; t[3] = v.w; }
        __syncthreads();
        if (kind == 4) {
            if (tid < 256) { const LAS bf16* tp = (const LAS bf16*)T + tid; float s = 0.f;
#pragma unroll 8
                for (int r = 0; r < 256; ++r) s += bf1(tp[r * 258]);
                ((float*)(ws + WS_KMEAN))[((size_t)(b * 4 + (tid >> 6)) * 32 + blk) * 64 + (tid & 63)] = s * (1.0f / 256.0f); }
            continue;
        }
#pragma unroll 1
        for (int q = 0; q < 16; ++q) {
            const int Tq = w * 16 + q, c = (Tq & 7) * 32 + (lane & 31), pg = (Tq >> 3) * 2 + (lane >> 5);
            const int kbase = 16 * (pg >> 1) + 4 * (pg & 1);
            const LAS bf16* tp = (const LAS bf16*)T + c;
            float v[8];
#pragma unroll
            for (int j = 0; j < 8; ++j) { const int key = kbase + (j & 3) + 8 * (j >> 2); v[j] = bf1(tp[key * 258]); }
            if (kind == 3) { const float lg = a.lg2g[c >> 6];
#pragma unroll
                for (int j = 0; j < 8; ++j) { const int key = kbase + (j & 3) + 8 * (j >> 2); v[j] *= __builtin_amdgcn_exp2f(lg * (float)(255 - key)); } }
            u32x4 o; o.x = pk2(v[0], v[1]); o.y = pk2(v[2], v[3]); o.z = pk2(v[4], v[5]); o.w = pk2(v[6], v[7]);
            *(u32x4*)(dst + (size_t)c * SEQ + blk * 256 + pg * 8) = o;
        }
    }
    __syncthreads();
}

constexpr int MB_KROW = 144, MB_VROW = 528, MB_KBYTES = 256 * MB_KROW, MB_STAGE = MB_KBYTES + 64 * MB_VROW;
constexpr int MB_LIST = MB_STAGE, MB_MISC = MB_STAGE + 16384;
static_assert(MB_MISC + 64 <= LDS_BYTES - 64, "moba lds");
constexpr size_t OUT_PO = 128 * MiB, OUT_PM = 224 * MiB, OUT_SEL = 232 * MiB;
constexpr int CTR_WORD0 = 3584;

__device__ __forceinline__ void moba_tile(const LAS unsigned char* Kb, const LAS unsigned char* Vb, int t, const bf16x8 (&qf)[4], f32x16& O0, f32x16& O1, float& mx, float& l, bool diag, int qpos, int ql, int hh) {
    const float C = 1.44269504089f;
    f32x16 s0, s1;
#pragma unroll
    for (int i = 0; i < 16; ++i) { s0[i] = 0.f; s1[i] = 0.f; }
#pragma unroll
    for (int ks = 0; ks < 4; ++ks) {
        const bf16x8 a0 = *(const LAS bf16x8*)(Kb + (64 * t + ql) * MB_KROW + (16 * ks + 8 * hh) * 2);
        const bf16x8 a1 = *(const LAS bf16x8*)(Kb + (64 * t + 32 + ql) * MB_KROW + (16 * ks + 8 * hh) * 2);
        s0 = MFMA32(a0, qf[ks], s0); s1 = MFMA32(a1, qf[ks], s1);
    }
    if (diag) {
#pragma unroll
        for (int i = 0; i < 16; ++i) { const int kl = 64 * t + crow(i, hh); if (kl > qpos) s0[i] = -INFINITY; if (kl + 32 > qpos) s1[i] = -INFINITY; }
    }
    float tmax = fmaxf(s0[0], s1[0]);
#pragma unroll
    for (int i = 1; i < 16; ++i) tmax = fmaxf(tmax, fmaxf(s0[i], s1[i]));
    tmax = fmaxf(tmax, __shfl_xor(tmax, 32));
    const float mxn = fmaxf(mx, tmax);
    const float alpha = __builtin_amdgcn_exp2f((mx - mxn) * C);
    const float mref = mxn * C;
    mx = mxn;
    float ls = 0.f;
#pragma unroll
    for (int i = 0; i < 16; ++i) { s0[i] = __builtin_amdgcn_exp2f(s0[i] * C - mref); s1[i] = __builtin_amdgcn_exp2f(s1[i] * C - mref); ls += s0[i] + s1[i]; }
    l = l * alpha + ls;
    if (__ballot(alpha != 1.0f) != 0ull) {
#pragma unroll
        for (int i = 0; i < 16; ++i) { O0[i] *= alpha; O1[i] *= alpha; }
    }
#pragma unroll
    for (int sb = 0; sb < 2; ++sb)
#pragma unroll
        for (int s2 = 0; s2 < 2; ++s2) {
            union { u32x4 u; bf16x8 v; } pb;
            if (sb == 0) { pb.u.x = pk2(s0[8 * s2], s0[8 * s2 + 1]); pb.u.y = pk2(s0[8 * s2 + 2], s0[8 * s2 + 3]); pb.u.z = pk2(s0[8 * s2 + 4], s0[8 * s2 + 5]); pb.u.w = pk2(s0[8 * s2 + 6], s0[8 * s2 + 7]); }
            else         { pb.u.x = pk2(s1[8 * s2], s1[8 * s2 + 1]); pb.u.y = pk2(s1[8 * s2 + 2], s1[8 * s2 + 3]); pb.u.z = pk2(s1[8 * s2 + 4], s1[8 * s2 + 5]); pb.u.w = pk2(s1[8 * s2 + 6], s1[8 * s2 + 7]); }
            const int kp = 64 * t + 32 * sb + 16 * s2 + 8 * hh;
            const bf16x8 v0 = *(const LAS bf16x8*)(Vb + ql * MB_VROW + kp * 2);
            const bf16x8 v1 = *(const LAS bf16x8*)(Vb + (32 + ql) * MB_VROW + kp * 2);
            O0 = MFMA32(v0, pb.v, O0); O1 = MFMA32(v1, pb.v, O1);
        }
}

#define MB_SOFT(s0, s1, mx, l, O0, O1) do { \
    float tmax_ = fmaxf(s0[0], s1[0]); _Pragma("unroll") for (int i = 1; i < 16; ++i) tmax_ = fmaxf(tmax_, fmaxf(s0[i], s1[i])); \
    tmax_ = fmaxf(tmax_, __shfl_xor(tmax_, 32)); const float mxn_ = fmaxf(mx, tmax_); const float alpha_ = __builtin_amdgcn_exp2f((mx - mxn_) * C); const float mref_ = mxn_ * C; mx = mxn_; \
    float ls_ = 0.f; _Pragma("unroll") for (int i = 0; i < 16; ++i) { s0[i] = __builtin_amdgcn_exp2f(s0[i] * C - mref_); s1[i] = __builtin_amdgcn_exp2f(s1[i] * C - mref_); ls_ += s0[i] + s1[i]; } \
    l = l * alpha_ + ls_; if (__ballot(alpha_ != 1.0f) != 0ull) { _Pragma("unroll") for (int i = 0; i < 16; ++i) { O0[i] *= alpha_; O1[i] *= alpha_; } } } while (0)
#define MB_PACK(dst, s, s2) do { dst.u.x = pk2(s[8 * (s2)], s[8 * (s2) + 1]); dst.u.y = pk2(s[8 * (s2) + 2], s[8 * (s2) + 3]); dst.u.z = pk2(s[8 * (s2) + 4], s[8 * (s2) + 5]); dst.u.w = pk2(s[8 * (s2) + 6], s[8 * (s2) + 7]); } while (0)
__device__ __forceinline__ void moba_tile2(const LAS unsigned char* Kb, const LAS unsigned char* Vb, int t, const bf16x8 (&qa)[4], const bf16x8 (&qb)[4],
                                           f32x16& A0, f32x16& A1, f32x16& B0, f32x16& B1, float& mxa, float& la, float& mxb, float& lb, int ql, int hh) {
    const float C = 1.44269504089f;
    f32x16 sa0, sa1, sb0, sb1;
#pragma unroll
    for (int i = 0; i < 16; ++i) { sa0[i] = 0.f; sa1[i] = 0.f; sb0[i] = 0.f; sb1[i] = 0.f; }
#pragma unroll
    for (int ks = 0; ks < 4; ++ks) {
        const bf16x8 a0 = *(const LAS bf16x8*)(Kb + (64 * t + ql) * MB_KROW + (16 * ks + 8 * hh) * 2);
        const bf16x8 a1 = *(const LAS bf16x8*)(Kb + (64 * t + 32 + ql) * MB_KROW + (16 * ks + 8 * hh) * 2);
        sa0 = MFMA32(a0, qa[ks], sa0); sa1 = MFMA32(a1, qa[ks], sa1); sb0 = MFMA32(a0, qb[ks], sb0); sb1 = MFMA32(a1, qb[ks], sb1);
    }
    MB_SOFT(sa0, sa1, mxa, la, A0, A1);
    MB_SOFT(sb0, sb1, mxb, lb, B0, B1);
#pragma unroll
    for (int sb = 0; sb < 2; ++sb)
#pragma unroll
        for (int s2 = 0; s2 < 2; ++s2) {
            union { u32x4 u; bf16x8 v; } pa, pb;
            if (sb == 0) { MB_PACK(pa, sa0, s2); MB_PACK(pb, sb0, s2); } else { MB_PACK(pa, sa1, s2); MB_PACK(pb, sb1, s2); }
            const int kp = 64 * t + 32 * sb + 16 * s2 + 8 * hh;
            const bf16x8 v0 = *(const LAS bf16x8*)(Vb + ql * MB_VROW + kp * 2);
            const bf16x8 v1 = *(const LAS bf16x8*)(Vb + (32 + ql) * MB_VROW + kp * 2);
            A0 = MFMA32(v0, pa.v, A0); A1 = MFMA32(v1, pa.v, A1); B0 = MFMA32(v0, pb.v, B0); B1 = MFMA32(v1, pb.v, B1);
        }
}
__device__ __forceinline__ void moba_put_partial(bf16* PO, float* PM, size_t pidx, const f32x16& O0, const f32x16& O1, float mx, float l, int hh) {
    const float inv = 1.0f / l;
    bf16* po = PO + pidx * 64 + 4 * hh;
#pragma unroll
    for (int i4 = 0; i4 < 4; ++i4) {
        u32x2 o0, o1;
        o0.x = pk2(O0[4 * i4] * inv, O0[4 * i4 + 1] * inv); o0.y = pk2(O0[4 * i4 + 2] * inv, O0[4 * i4 + 3] * inv);
        o1.x = pk2(O1[4 * i4] * inv, O1[4 * i4 + 1] * inv); o1.y = pk2(O1[4 * i4 + 2] * inv, O1[4 * i4 + 3] * inv);
        *(u32x2*)(po + 8 * i4) = o0; *(u32x2*)(po + 32 + 8 * i4) = o1;
    }
    if (hh == 0) { PM[pidx * 2] = mx; PM[pidx * 2 + 1] = l; }
}
#define MB_STAGE_LOAD(Kg, Vg, m) u32x4 sk_[4], sv_[4]; _Pragma("unroll") for (int c = 0; c < 4; ++c) { const int ch = tl + NTHR * c; \
        sk_[c] = *(const u32x4*)((Kg) + (size_t)((m) * 256 + (ch >> 3)) * INC + (ch & 7) * 8); sv_[c] = *(const u32x4*)((Vg) + (size_t)(ch >> 5) * SEQ + (m) * 256 + (ch & 31) * 8); }
#define MB_STAGE_STORE() do { _Pragma("unroll") for (int c = 0; c < 4; ++c) { const int ch = tl + NTHR * c; *(LAS u32x4*)(lds + (ch >> 3) * MB_KROW + (ch & 7) * 16) = sk_[c]; *(LAS u32x4*)(lds + MB_KBYTES + (ch >> 5) * MB_VROW + (ch & 31) * 16) = sv_[c]; } } while (0)

__device__ __forceinline__ void moba_gate_phase(const Args& a, LAS unsigned char* lds, int tid, int G, unsigned char* ws_, unsigned char* outb_) {
    unsigned char* ws = ws_; unsigned char* outb = outb_; (void)outb; const bf16* Z = (const bf16*)(ws + WS_HZ); const float* km = (const float*)(ws + WS_KMEAN); unsigned* SEL = (unsigned*)(outb + OUT_SEL);
    const int lane = tid & 63, w = tid >> 6, ql = lane & 31, hh = lane >> 5;
    for (int e = blockIdx.x; e < BATCH * 4 * 32; e += G) {
        const int bh = e & 31, n = e >> 5, b = bh >> 2, h = bh & 3;
        const size_t rowq = (size_t)b * SEQ + n * 256 + w * 32 + ql;
        unsigned* selp = SEL + (size_t)bh * SEQ + n * 256 + w * 32 + ql;
        if (n == 0) { if (hh == 0) *selp = 0xFFFFFFu; continue; }
        __syncthreads();
        { const f32x4 v = *(const f32x4*)(km + (size_t)bh * 2048 + tid * 4); *(LAS f32x4*)(lds + tid * 16) = v; }
        float q[64];
        { const u32x4* qp = (const u32x4*)(Z + rowq * INC + ZMQ + h * 64);
#pragma unroll
          for (int c = 0; c < 8; ++c) { const u32x4 wv = qp[c]; q[8 * c] = bflo(wv.x); q[8 * c + 1] = bfhi(wv.x); q[8 * c + 2] = bflo(wv.y); q[8 * c + 3] = bfhi(wv.y); q[8 * c + 4] = bflo(wv.z); q[8 * c + 5] = bfhi(wv.z); q[8 * c + 6] = bflo(wv.w); q[8 * c + 7] = bfhi(wv.w); } }
        __syncthreads();
        float g0 = -INFINITY, g1 = -INFINITY, g2 = -INFINITY; int i0 = 255, i1 = 255, i2 = 255;
#define MB_INS(g, m) do { if ((g) > g0 || ((g) == g0 && (m) < i0)) { g2 = g1; i2 = i1; g1 = g0; i1 = i0; g0 = (g); i0 = (m); } \
        else if ((g) > g1 || ((g) == g1 && (m) < i1)) { g2 = g1; i2 = i1; g1 = (g); i1 = (m); } \
        else if ((g) > g2 || ((g) == g2 && (m) < i2)) { g2 = (g); i2 = (m); } } while (0)
        const int mend = (n < 16 * hh + 16) ? n : 16 * hh + 16;
        for (int m = 16 * hh; m < mend; ++m) {
            const LAS f32x4* kp = (const LAS f32x4*)(lds + m * 256);
            float g = 0.f;
#pragma unroll
            for (int c = 0; c < 16; ++c) { const f32x4 kv = kp[c]; g += q[4 * c] * kv[0] + q[4 * c + 1] * kv[1] + q[4 * c + 2] * kv[2] + q[4 * c + 3] * kv[3]; }
            MB_INS(g, m);
        }
        const float pg0 = __shfl_xor(g0, 32), pg1 = __shfl_xor(g1, 32), pg2 = __shfl_xor(g2, 32);
        const int pi0 = __shfl_xor(i0, 32), pi1 = __shfl_xor(i1, 32), pi2 = __shfl_xor(i2, 32);
        if (pi0 < 255) MB_INS(pg0, pi0);
        if (pi1 < 255) MB_INS(pg1, pi1);
        if (pi2 < 255) MB_INS(pg2, pi2);
#undef MB_INS
        if (hh == 0) *selp = (unsigned)i0 | ((unsigned)i1 << 8) | ((unsigned)i2 << 16);
    }
    __syncthreads();
}

__device__ __forceinline__ void moba_past_phase(const Args& a, int L, LAS unsigned char* lds, int tid, int G, unsigned char* ws_, unsigned char* outb_) {
    unsigned char* ws = ws_; unsigned char* outb = outb_; (void)outb; const bf16* Z = (const bf16*)(ws + WS_HZ); const bf16* VTM = (const bf16*)((const unsigned char*)outb + OUT_VTM);
    const unsigned* SEL = (const unsigned*)((const unsigned char*)outb + OUT_SEL); bf16* PO = (bf16*)(outb + OUT_PO); float* PM = (float*)(outb + OUT_PM);
    unsigned* ctr = (unsigned*)ws + CTR_WORD0 + 64 * L;
    const int lane = tid & 63, w = tid >> 6, ql = lane & 31, hh = lane >> 5;
    LAS unsigned short* list = (LAS unsigned short*)(lds + MB_LIST); LAS unsigned* misc = (LAS unsigned*)(lds + MB_MISC);
    for (;;) {
        __syncthreads();
        if (tid == 0) { misc[0] = __hip_atomic_fetch_add(ctr, 1u, __ATOMIC_RELAXED, __HIP_MEMORY_SCOPE_AGENT); misc[1] = 0u; }
        __syncthreads();
        const int e = (int)misc[0];
        if (e >= 31 * 32) break;
        const int m = e >> 5, bh = e & 31, b = bh >> 2, h = bh & 3;
        int tl = tid; asm volatile("" : "+v"(tl));
        const bf16* Kg = Z + (size_t)b * SEQ * INC + ZMK + h * 64; const bf16* Vg = VTM + ((size_t)b * 256 + h * 64) * SEQ;
        MB_STAGE_LOAD(Kg, Vg, m);
        for (int s0 = (m + 1) * 256 + tl; s0 < SEQ; s0 += 4 * NTHR) {
            unsigned sv4[4];
#pragma unroll
            for (int u = 0; u < 4; ++u) { const int s = s0 + u * NTHR; sv4[u] = (s < SEQ) ? SEL[(size_t)bh * SEQ + s] : 0xFFFFFFu; }
#pragma unroll
            for (int u = 0; u < 4; ++u) { const int s = s0 + u * NTHR; const unsigned sel = sv4[u];
#pragma unroll
                for (int t = 0; t < 3; ++t) if (((sel >> (8 * t)) & 0xFFu) == (unsigned)m) { const unsigned pos = __hip_atomic_fetch_add((unsigned*)(misc + 1), 1u, __ATOMIC_RELAXED, __HIP_MEMORY_SCOPE_WORKGROUP); list[pos] = (unsigned short)(s | (t << 13)); } }
        }
        MB_STAGE_STORE();
        __syncthreads();
        const int cnt = (int)misc[1];
        for (int c0 = 0; c0 < cnt; c0 += 512) {
            const int ia = c0 + w * 64 + ql, ib = ia + 32;
            if (c0 + w * 64 >= cnt) continue;
            const bool va = ia < cnt, vb = ib < cnt, two = (c0 + w * 64 + 32) < cnt;
            const unsigned ea = list[va ? ia : cnt - 1], eb = list[vb ? ib : cnt - 1];
            bf16x8 qa[4], qb[4];
#pragma unroll
            for (int ks = 0; ks < 4; ++ks) { qa[ks] = *(const bf16x8*)(Z + ((size_t)b * SEQ + (ea & 8191)) * INC + ZMQ + h * 64 + ks * 16 + hh * 8);
                                             qb[ks] = *(const bf16x8*)(Z + ((size_t)b * SEQ + (eb & 8191)) * INC + ZMQ + h * 64 + ks * 16 + hh * 8); }
            f32x16 A0, A1, B0, B1;
#pragma unroll
            for (int i = 0; i < 16; ++i) { A0[i] = 0.f; A1[i] = 0.f; B0[i] = 0.f; B1[i] = 0.f; }
            float mxa = -1e30f, la = 0.f, mxb = -1e30f, lb = 0.f;
            if (two) {
#pragma unroll 1
                for (int t = 0; t < 4; ++t) moba_tile2(lds, lds + MB_KBYTES, t, qa, qb, A0, A1, B0, B1, mxa, la, mxb, lb, ql, hh);
            } else {
#pragma unroll 1
                for (int t = 0; t < 4; ++t) moba_tile(lds, lds + MB_KBYTES, t, qa, A0, A1, mxa, la, false, 0, ql, hh);
            }
            la += __shfl_xor(la, 32); lb += __shfl_xor(lb, 32);
            if (va) moba_put_partial(PO, PM, ((size_t)bh * SEQ + (ea & 8191)) * 3 + (ea >> 13), A0, A1, mxa, la, hh);
            if (two && vb) moba_put_partial(PO, PM, ((size_t)bh * SEQ + (eb & 8191)) * 3 + (eb >> 13), B0, B1, mxb, lb, hh);
        }
    }
    __syncthreads();
}

__device__ __forceinline__ void moba_own_phase(const Args& a, LAS unsigned char* lds, int tid, int G, unsigned char* ws_, unsigned char* outb_) {
    unsigned char* ws = ws_; unsigned char* outb = outb_; (void)outb; const bf16* Z = (const bf16*)(ws + WS_HZ); bf16* Y = (bf16*)(ws + WS_Y); const bf16* VTM = (const bf16*)((const unsigned char*)outb + OUT_VTM);
    const bf16* PO = (const bf16*)((const unsigned char*)outb + OUT_PO); const float* PM = (const float*)((const unsigned char*)outb + OUT_PM);
    const int lane = tid & 63, w = tid >> 6, ql = lane & 31, hh = lane >> 5;
    const float C = 1.44269504089f;
    for (int e = blockIdx.x; e < BATCH * 4 * 32; e += G) {
        const int bh = e & 31, n = e >> 5, b = bh >> 2, h = bh & 3;
        const int sq = n * 256 + w * 32 + ql; const size_t rowq = (size_t)b * SEQ + sq;
        __syncthreads();
        int tl = tid; asm volatile("" : "+v"(tl));
        const bf16* Kg = Z + (size_t)b * SEQ * INC + ZMK + h * 64; const bf16* Vg = VTM + ((size_t)b * 256 + h * 64) * SEQ;
        MB_STAGE_LOAD(Kg, Vg, n);
        bf16x8 qf[4];
#pragma unroll
        for (int ks = 0; ks < 4; ++ks) qf[ks] = *(const bf16x8*)(Z + rowq * INC + ZMQ + h * 64 + ks * 16 + hh * 8);
        MB_STAGE_STORE();
        __syncthreads();
        f32x16 O0, O1;
#pragma unroll
        for (int i = 0; i < 16; ++i) { O0[i] = 0.f; O1[i] = 0.f; }
        float mx = -1e30f, l = 0.f;
        const int qpos = w * 32 + ql, nt = (w >> 1) + 1;
#pragma unroll 1
        for (int t = 0; t < nt; ++t) moba_tile(lds, lds + MB_KBYTES, t, qf, O0, O1, mx, l, t == nt - 1, qpos, ql, hh);
        l += __shfl_xor(l, 32);
        const int nsel = n < 3 ? n : 3;
        const size_t pbase = ((size_t)bh * SEQ + sq) * 3;
        float mt[3], lt[3], M = mx;
#pragma unroll
        for (int t = 0; t < 3; ++t) { mt[t] = -1e30f; lt[t] = 0.f; if (t < nsel) { mt[t] = PM[(pbase + t) * 2]; lt[t] = PM[(pbase + t) * 2 + 1]; M = fmaxf(M, mt[t]); } }
        const float wo = __builtin_amdgcn_exp2f((mx - M) * C);
        float Lsum = l * wo;
#pragma unroll
        for (int i = 0; i < 16; ++i) { O0[i] *= wo; O1[i] *= wo; }
#pragma unroll
        for (int t = 0; t < 3; ++t) if (t < nsel) {
            const float wt = __builtin_amdgcn_exp2f((mt[t] - M) * C) * lt[t]; Lsum += wt;
            const bf16* po = PO + (pbase + t) * 64 + 4 * hh;
#pragma unroll
            for (int i4 = 0; i4 < 4; ++i4) { const u32x2 p0 = *(const u32x2*)(po + 8 * i4), p1 = *(const u32x2*)(po + 32 + 8 * i4);
                O0[4 * i4] += wt * bflo(p0.x); O0[4 * i4 + 1] += wt * bfhi(p0.x); O0[4 * i4 + 2] += wt * bflo(p0.y); O0[4 * i4 + 3] += wt * bfhi(p0.y);
                O1[4 * i4] += wt * bflo(p1.x); O1[4 * i4 + 1] += wt * bfhi(p1.x); O1[4 * i4 + 2] += wt * bflo(p1.y); O1[4 * i4 + 3] += wt * bfhi(p1.y); }
        }
        const float inv = 1.0f / Lsum;
        bf16* yp = Y + rowq * D + 768 + h * 64 + 4 * hh;
#pragma unroll
        for (int i4 = 0; i4 < 4; ++i4) {
            u32x2 o0, o1;
            o0.x = pk2(O0[4 * i4] * inv, O0[4 * i4 + 1] * inv); o0.y = pk2(O0[4 * i4 + 2] * inv, O0[4 * i4 + 3] * inv);
            o1.x = pk2(O1[4 * i4] * inv, O1[4 * i4 + 1] * inv); o1.y = pk2(O1[4 * i4 + 2] * inv, O1[4 * i4 + 3] * inv);
            *(u32x2*)(yp + 8 * i4) = o0; *(u32x2*)(yp + 32 + 8 * i4) = o1;
        }
    }
    __syncthreads();
}

__device__ __forceinline__ void ret_kv_phase(const Args& a, int tid, int G, unsigned char* ws_, unsigned char* outb_) {
    unsigned char* ws = ws_; unsigned char* outb = outb_; (void)outb; const bf16* VTR = (const bf16*)((const unsigned char*)outb + OUT_VTR); const bf16* KTZ = (const bf16*)((const unsigned char*)outb + OUT_KTZ); float* KV = (float*)(ws + WS_KV);
    const int lane = tid & 63, w = tid >> 6, ql = lane & 31, hh = lane >> 5, eb = w >> 1, db = w & 1;
    for (int it = blockIdx.x; it < BATCH * 4 * 32; it += G) {
        const int j = it & 31, h = (it >> 5) & 3, b = it >> 7;
        const bf16* ap = VTR + ((size_t)b * 512 + h * 128 + eb * 32 + ql) * SEQ + j * 256 + 8 * hh;
        const bf16* bp = KTZ + ((size_t)b * 256 + h * 64 + db * 32 + ql) * SEQ + j * 256 + 8 * hh;
        f32x16 acc;
#pragma unroll
        for (int i = 0; i < 16; ++i) acc[i] = 0.f;
#pragma unroll
        for (int half = 0; half < 2; ++half) {
            bf16x8 av[8], bv[8];
#pragma unroll
            for (int s = 0; s < 8; ++s) { av[s] = *(const bf16x8*)(ap + (half * 8 + s) * 16); bv[s] = *(const bf16x8*)(bp + (half * 8 + s) * 16); }
#pragma unroll
            for (int s = 0; s < 8; ++s) acc = MFMA32(av[s], bv[s], acc);
        }
        float* o = KV + (size_t)it * 8192 + (size_t)(eb * 32) * 64 + db * 32 + ql;
#pragma unroll
        for (int i = 0; i < 16; ++i) o[crow(i, hh) * 64] = acc[i];
    }
}
__device__ __forceinline__ void ret_scan_phase(const Args& a, int tid, int G, unsigned char* ws_, unsigned char* outb_) {
    unsigned char* ws = ws_; unsigned char* outb = outb_; (void)outb; const float* KV = (const float*)(ws + WS_KV); bf16* RSb = (bf16*)(ws + WS_RS);
    for (int i = blockIdx.x * NTHR + tid; i < 32 * 4096; i += G * NTHR) {
        const int bh = i >> 12, el = (i & 4095) * 2; const float gC = __builtin_amdgcn_exp2f(a.lg2g[bh & 3] * 256.0f);
        float S0 = 0.f, S1 = 0.f;
        for (int j = 0; j < 32; ++j) { const size_t o = ((size_t)bh * 32 + j) * 8192 + el; *(unsigned*)(RSb + o) = pk2(S0, S1); const float k0 = KV[o], k1 = KV[o + 1]; S0 = gC * S0 + k0; S1 = gC * S1 + k1; }
    }
}
constexpr int RT_KROW = 144, RT_VROW = 528, RT_KBYTES = 256 * RT_KROW;
static_assert(RT_KBYTES + 128 * RT_VROW <= LDS_BYTES, "ret lds");
__device__ __forceinline__ void ret_out_phase(const Args& a, LAS unsigned char* lds, int tid, int G, unsigned char* ws_, unsigned char* outb_) {
    unsigned char* ws = ws_; unsigned char* outb = outb_; (void)outb;
    const bf16* Z = (const bf16*)(ws + WS_HZ); bf16* Y = (bf16*)(ws + WS_Y); const bf16* VTR = (const bf16*)((const unsigned char*)outb + OUT_VTR); const bf16* RSb = (const bf16*)(ws + WS_RS);
    const int lane = tid & 63, w = tid >> 6, ql = lane & 31, hh = lane >> 5;
    for (int it = blockIdx.x; it < BATCH * 4 * 32; it += G) {
        const int j = it & 31, h = (it >> 5) & 3, b = it >> 7;
        const size_t rowc = (size_t)b * SEQ + j * 256, rowq = rowc + w * 32 + ql;
        const float lg = a.lg2g[h];
        __syncthreads();
        int tl = tid; asm volatile("" : "+v"(tl));
        u32x4 stk[4], stv[8];
#pragma unroll
        for (int c = 0; c < 4; ++c) { const int ch = tl + NTHR * c; stk[c] = *(const u32x4*)(Z + (rowc + (ch >> 3)) * INC + ZK + h * 64 + (ch & 7) * 8); }
#pragma unroll
        for (int c = 0; c < 8; ++c) { const int ch = tl + NTHR * c; stv[c] = *(const u32x4*)(VTR + ((size_t)b * 512 + h * 128 + (ch >> 5)) * SEQ + j * 256 + (ch & 31) * 8); }
        bf16x8 qf[4];
#pragma unroll
        for (int ks = 0; ks < 4; ++ks) qf[ks] = *(const bf16x8*)(Z + rowq * INC + ZQ + h * 64 + ks * 16 + hh * 8);
        f32x16 O[4];
#pragma unroll
        for (int eb = 0; eb < 4; ++eb) {
#pragma unroll
            for (int i = 0; i < 16; ++i) O[eb][i] = 0.f;
            const bf16* rp = RSb + (size_t)it * 8192 + (size_t)(eb * 32 + ql) * 64 + 8 * hh;
#pragma unroll
            for (int ks = 0; ks < 4; ++ks) { const bf16x8 ra = *(const bf16x8*)(rp + ks * 16); O[eb] = MFMA32(ra, qf[ks], O[eb]); }
            __builtin_amdgcn_sched_barrier(0);
        }
        const int qpos = w * 32 + ql;
        { const float xi = __builtin_amdgcn_exp2f(lg * (float)(qpos + 1));
#pragma unroll
          for (int eb = 0; eb < 4; ++eb)
#pragma unroll
              for (int i = 0; i < 16; ++i) O[eb][i] *= xi; }
#pragma unroll
        for (int c = 0; c < 4; ++c) { const int ch = tl + NTHR * c; *(LAS u32x4*)(lds + (ch >> 3) * RT_KROW + (ch & 7) * 16) = stk[c]; }
#pragma unroll
        for (int c = 0; c < 8; ++c) { const int ch = tl + NTHR * c; *(LAS u32x4*)(lds + RT_KBYTES + (ch >> 5) * RT_VROW + (ch & 31) * 16) = stv[c]; }
        __syncthreads();
        for (int kb = 0; kb <= w; ++kb) {
            f32x16 s;
#pragma unroll
            for (int i = 0; i < 16; ++i) s[i] = 0.f;
#pragma unroll
            for (int ks = 0; ks < 4; ++ks) { const bf16x8 ka = *(const LAS bf16x8*)(lds + (32 * kb + ql) * RT_KROW + (16 * ks + 8 * hh) * 2); s = MFMA32(ka, qf[ks], s); }
#pragma unroll
            for (int i = 0; i < 16; ++i) { const int diff = qpos - 32 * kb - crow(i, hh); const float fdec = __builtin_amdgcn_exp2f(lg * (float)diff); s[i] = diff >= 0 ? s[i] * fdec : 0.f; }
#pragma unroll
            for (int s2 = 0; s2 < 2; ++s2) {
                union { u32x4 u; bf16x8 v; } pb;
                pb.u.x = pk2(s[8 * s2], s[8 * s2 + 1]); pb.u.y = pk2(s[8 * s2 + 2], s[8 * s2 + 3]); pb.u.z = pk2(s[8 * s2 + 4], s[8 * s2 + 5]); pb.u.w = pk2(s[8 * s2 + 6], s[8 * s2 + 7]);
                const int kp = 32 * kb + 16 * s2 + 8 * hh;
#pragma unroll
                for (int eb = 0; eb < 4; ++eb) { const bf16x8 va = *(const LAS bf16x8*)(lds + RT_KBYTES + (eb * 32 + ql) * RT_VROW + kp * 2); O[eb] = MFMA32(va, pb.v, O[eb]); }
            }
        }
        float s1 = 0.f;
#pragma unroll
        for (int eb = 0; eb < 4; ++eb)
#pragma unroll
            for (int i = 0; i < 16; ++i) s1 += O[eb][i];
        s1 += __shfl_xor(s1, 32);
        const float mean = s1 * (1.0f / 128.0f); float s2 = 0.f;
#pragma unroll
        for (int eb = 0; eb < 4; ++eb)
#pragma unroll
            for (int i = 0; i < 16; ++i) { O[eb][i] -= mean; s2 += O[eb][i] * O[eb][i]; }
        s2 += __shfl_xor(s2, 32);
        const float rstd = 1.0f / sqrtf(s2 * (1.0f / 128.0f) + 1e-6f);
        const bf16* gp = Z + rowq * INC + ZG + h * 128 + 4 * hh; bf16* yp = Y + rowq * D + h * 128 + 4 * hh;
#pragma unroll
        for (int eb = 0; eb < 4; ++eb)
#pragma unroll
            for (int i4 = 0; i4 < 4; ++i4) {
                const u32x2 gw = *(const u32x2*)(gp + eb * 32 + 8 * i4);
                const float r0 = O[eb][4 * i4] * rstd * pg8::silu_f(bflo(gw.x)), r1 = O[eb][4 * i4 + 1] * rstd * pg8::silu_f(bfhi(gw.x)),
                            r2 = O[eb][4 * i4 + 2] * rstd * pg8::silu_f(bflo(gw.y)), r3 = O[eb][4 * i4 + 3] * rstd * pg8::silu_f(bfhi(gw.y));
                u32x2 o; o.x = pk2(r0, r1); o.y = pk2(r2, r3); *(u32x2*)(yp + eb * 32 + 8 * i4) = o;
            }
    }
    __syncthreads();
}

__device__ __forceinline__ void phase_m1(const Args& a, int L, LAS unsigned char* lds, int tid, int G, unsigned char* ws_, unsigned char* outb_) {
    unsigned char* ws = ws_; unsigned char* outb = outb_; (void)outb;
    const bf16* Z = (const bf16*)(ws + WS_HZ); bf16* Y = (bf16*)(ws + WS_Y);
    const int lane = tid & 63, w = tid >> 6, ql = lane & 31, hh = lane >> 5, g = w >> 1, db = w & 1;
    LAS bf16* U = (LAS bf16*)lds;
    LAS bf16* Pb = (LAS bf16*)(lds + 24576);
    const float* pw = a.in[8] + (size_t)L * 4 * 64 * 64; const float scl = a.in[9][L * 256 + g * 64 + db * 32 + ql];
    bf16x8 wb[4];
#pragma unroll
    for (int ks = 0; ks < 4; ++ks) { float v[8];
#pragma unroll
        for (int j = 0; j < 8; ++j) v[j] = pw[(size_t)(g * 64 + ks * 16 + hh * 8 + j) * 64 + db * 32 + ql];
        union { u32x4 u; bf16x8 b; } t; t.u.x = pk2(v[0], v[1]); t.u.y = pk2(v[2], v[3]); t.u.z = pk2(v[4], v[5]); t.u.w = pk2(v[6], v[7]); wb[ks] = t.b; }
    for (int tile = blockIdx.x; tile < M / 32; tile += G) {
        const int r0 = tile * 32, sp0 = r0 & (SEQ - 1);
        __syncthreads();
        for (int c = tid; c < 47 * 32; c += NTHR) { const int i = c >> 5, cc = c & 31;
            if (sp0 + i - 15 >= 0) *(LAS u32x4*)(U + i * 256 + cc * 8) = *(const u32x4*)(Z + (size_t)(r0 + i - 15) * INC + ZP + cc * 8); }
        __syncthreads();
#pragma unroll 4
        for (int k = 0; k < 16; ++k) {
            const int idx = tid + NTHR * k, t = idx >> 8, ch = idx & 255, win = 2 << (ch >> 6);
            const int sp = sp0 + t; const int nb = (sp + 1 < win) ? (sp + 1) : win;
            const LAS bf16* up = U + (15 + t) * 256 + ch;
            float s = 0.f;
#pragma unroll
            for (int ww = 0; ww < 16; ++ww) if (ww < nb) s += bf1(up[-ww * 256]);
            Pb[t * 264 + ch] = (bf16)f2bf(s / (float)nb - bf1(up[0]));
        }
        __syncthreads();
        f32x16 acc;
#pragma unroll
        for (int i = 0; i < 16; ++i) acc[i] = 0.f;
#pragma unroll
        for (int ks = 0; ks < 4; ++ks) { const bf16x8 pa = *(const LAS bf16x8*)(Pb + ql * 264 + g * 64 + ks * 16 + hh * 8); acc = MFMA32(pa, wb[ks], acc); }
        bf16* yp = Y + (size_t)r0 * D + 512 + g * 64 + db * 32 + ql;
#pragma unroll
        for (int i = 0; i < 16; ++i) yp[(size_t)crow(i, hh) * D] = (bf16)f2bf(acc[i] * scl);
    }
    __syncthreads();
}

__device__ __forceinline__ void phase_final(const Args& a, int lane, int wave, int G) {
    const float* g = a.in[18]; float* xo = a.out; const bf16* xb = (const bf16*)(a.ws + WS_XB2);
    const int gw = blockIdx.x * NWAVES + wave, NGW = G * NWAVES;
    const f32x4* gp = (const f32x4*)g + lane;
    for (int m = gw; m < M; m += NGW) {
        const u32x2* br = (const u32x2*)(xb + (size_t)m * D) + lane; f32x4* xr = (f32x4*)(xo + (size_t)m * D) + lane; f32x4 v[4]; float s = 0.f;
#pragma unroll
        for (int j = 0; j < 4; ++j) { const u32x2 w = br[64 * j]; v[j][0] = bflo(w.x); v[j][1] = bfhi(w.x); v[j][2] = bflo(w.y); v[j][3] = bfhi(w.y); s += (v[j][0] * v[j][0] + v[j][1] * v[j][1]) + (v[j][2] * v[j][2] + v[j][3] * v[j][3]); }
        const float r = 1.0f / sqrtf(wave_sum(s) * (1.0f / D) + 1e-6f);
#pragma unroll
        for (int j = 0; j < 4; ++j) xr[64 * j] = v[j] * r * gp[64 * j];
    }
}

#define RLX_AGENT __ATOMIC_RELAXED, __HIP_MEMORY_SCOPE_AGENT
#define XB_TMO      128
#define XB_XCNT(j)  (256  + 64 * (j))
#define XB_XSUB(j)  (1280 + 64 * (j))
#define XB_XGEN(j)  (2304 + 64 * (j))
#define XB_TOP      3328
#define XB_TOPGEN   3392
#define XCD_BAR_WORDS 3456
#define XB_SPIN_CAP (1u << 18)

__device__ __forceinline__ unsigned xb_ld(unsigned* p)              { return __hip_atomic_load(p, __ATOMIC_RELAXED, __HIP_MEMORY_SCOPE_AGENT); }
__device__ __forceinline__ unsigned xb_add(unsigned* p, unsigned v) { return __hip_atomic_fetch_add(p, v, __ATOMIC_RELAXED, __HIP_MEMORY_SCOPE_AGENT); }
__device__ __forceinline__ unsigned xb_xcc_id() { return (unsigned)__builtin_amdgcn_s_getreg((3 << 11) | 20) & 0xFu; }
#define XB_SPIN(cond, bar) do { unsigned _sp = 0; while (cond) { __builtin_amdgcn_s_sleep(1); \
    if ((++_sp & 255u) == 0u) { if (xb_ld(&(bar)[XB_TMO])) break; if (_sp > XB_SPIN_CAP) { atomicAdd(&(bar)[XB_TMO], 1u); break; } } } } while (0)

struct XcdBarrier {
    unsigned* bar; unsigned x;
    volatile LAS unsigned* st;
};

__device__ __forceinline__ XcdBarrier xcd_barrier_post(unsigned* bar, volatile LAS unsigned* st) {
    XcdBarrier b; b.bar = bar; b.x = xb_xcc_id(); b.st = st;
    if (threadIdx.x == 0) (void)xb_add(&bar[XB_XCNT(b.x)], 1u);
    return b;
}
__device__ __forceinline__ void xcd_barrier_complete(unsigned* bar, unsigned x, unsigned& nloc, unsigned& nx) {
    const unsigned G = gridDim.x * gridDim.y * gridDim.z;
    unsigned sum, cnt, mine, sp = 0u;
    for (;;) {
        sum = 0u; cnt = 0u; mine = 0u;
#pragma unroll
        for (unsigned j = 0; j < 16; ++j) { const unsigned c = xb_ld(&bar[XB_XCNT(j)]); sum += c; cnt += (c > 0u) ? 1u : 0u; mine = (j == x) ? c : mine; }
        if (sum == G) break;
        __builtin_amdgcn_s_sleep(1);
        if ((++sp & 255u) == 0u) { if (xb_ld(&bar[XB_TMO])) break; if (sp > XB_SPIN_CAP) { atomicAdd(&bar[XB_TMO], 1u); break; } }
    }
    nloc = mine > 0u ? mine : 1u; nx = cnt > 0u ? cnt : 1u;
}

__device__ __noinline__ void xcd_barrier_fn(unsigned* bar_, volatile LAS unsigned* st_) {
    XcdBarrier b; b.bar = bar_; b.x = xb_xcc_id(); b.st = st_;
    asm volatile("s_waitcnt vmcnt(0)" ::: "memory");
    __syncthreads();
    if (threadIdx.x == 0) {
        unsigned* bar = b.bar;
        __builtin_amdgcn_s_waitcnt(0);
        unsigned nloc = b.st[0], nx = b.st[1];
        if (nloc == 0u) { xcd_barrier_complete(bar, b.x, nloc, nx); b.st[0] = nloc; b.st[1] = nx; }
        const unsigned old = xb_add(&bar[XB_XSUB(b.x)], 1u);
        const unsigned gen = old / nloc;
        if (old + 1u == (gen + 1u) * nloc) {
            __builtin_amdgcn_fence(__ATOMIC_RELEASE, "agent");
            asm volatile("s_waitcnt vmcnt(0)" ::: "memory");
            const unsigned og = xb_add(&bar[XB_TOP], 1u);
            const unsigned tg = og / nx;
            if (og + 1u == (tg + 1u) * nx) xb_add(&bar[XB_TOPGEN], 1u);
            else XB_SPIN(xb_ld(&bar[XB_TOPGEN]) == tg, bar);
            __builtin_amdgcn_fence(__ATOMIC_ACQUIRE, "agent");
            xb_add(&bar[XB_XGEN(b.x)], 1u);
            asm volatile("s_waitcnt vmcnt(0)" ::: "memory");
        } else {
            XB_SPIN(xb_ld(&bar[XB_XGEN(b.x)]) == gen, bar);
            __builtin_amdgcn_fence(__ATOMIC_ACQUIRE, "agent");
            asm volatile("s_waitcnt vmcnt(0)" ::: "memory");
        }
    }
    __syncthreads();
}

constexpr int N_PHASES = 2 + 11 * DEPTH;
__global__ void __launch_bounds__(NTHR, 2) mega_fwd(Args a) {
    extern __shared__ __attribute__((aligned(16))) unsigned char lds_raw[];
    LAS unsigned char* lds = (LAS unsigned char*)lds_raw;
    cg::grid_group grid = cg::this_grid();
    int tid = threadIdx.x, lane = tid & 63, G = gridDim.x; const int wave = __builtin_amdgcn_readfirstlane(tid >> 6);
    unsigned char* ws = a.ws; unsigned char* outb = (unsigned char*)a.out;
    bf16* XB = (bf16*)(ws + WS_XB); bf16* HZ = (bf16*)(ws + WS_HZ); bf16* Y = (bf16*)(ws + WS_Y);
    float* SS0 = (float*)(ws + WS_SS0); float* SS1 = (float*)(ws + WS_SS1); const float* CS = (const float*)(ws + WS_CS);
    const int lo = a.ph_lo, hi = a.ph_hi;
    volatile LAS unsigned* bst = (volatile LAS unsigned*)(lds + LDS_BYTES - 64);
    if (tid < 2) bst[tid] = 0u;
    if (blockIdx.x == 0) for (int i = tid; i < 4096; i += NTHR) __hip_atomic_store((unsigned*)a.ws + i, 0u, RLX_AGENT);
    __syncthreads();
#define FRESH() do { asm volatile("" : "+s"(ws)); asm volatile("" : "+s"(outb)); asm volatile("" : "+s"(G)); asm volatile("" : "+v"(tid)); lane = tid & 63; XB = (bf16*)(ws + WS_XB); HZ = (bf16*)(ws + WS_HZ); Y = (bf16*)(ws + WS_Y); SS0 = (float*)(ws + WS_SS0); SS1 = (float*)(ws + WS_SS1); CS = (const float*)(ws + WS_CS); } while (0)
#ifndef PH_MASK
#define PH_MASK 0x1FFFu
#endif
#define EN(j) ((PH_MASK >> (j)) & 1u)
#ifndef REP_MASK
#define REP_MASK 0u
#endif
#define NREP(j) (1 + (int)((REP_MASK >> (j)) & 1u))
#define IN(k) (lo <= (k) && (k) < hi)
#define SEAM(k) do { if (IN(k) && IN((k) + 1)) xcd_barrier_fn((unsigned*)a.ws, (volatile LAS unsigned*)(lds + LDS_BYTES - 64)); } while (0)
    if (EN(11) && IN(0)) { _Pragma("unroll 1") for (int rep = 0; rep < NREP(11); ++rep) { phase_prologue(a, lds, tid, lane, wave, G); } } if (IN(0) && IN(1)) { grid.sync(); } (void)xcd_barrier_post((unsigned*)a.ws, bst);
#pragma unroll 1
    for (int L = 0; L < DEPTH; ++L) {
        const int pb = 1 + 11 * L;
#define WL() const bf16* wl = (const bf16*)(ws + WS_W) + (size_t)L * W_LAYER
        if (EN(0) && IN(pb + 0)) { FRESH(); WL(); pg8::Gemm g{(const bf16*)(ws + WS_XB2), wl + W_GU1, M, 2 * FF, D}; pg8::StaticOrder S; S.init(M, 2 * FF, G, (int)blockIdx.x); pg8::EpiGLU E{HZ, FF, SS0};
            _Pragma("unroll 1") for (int rep = 0; rep < NREP(0); ++rep) { pg8::gemm_phase<pg8::EpiGLU, pg8::StaticOrder, true, true>(lds, g, S, E); } } SEAM(pb + 0);
        if (EN(1) && IN(pb + 1)) { FRESH(); WL(); pg8::Gemm g{HZ, wl + W_D1, M, D, FF}; pg8::StaticOrder S; S.init(M, D, G, (int)blockIdx.x); pg8::EpiRes<0> E{(const bf16*)(ws + WS_XB2), XB, SS1, 0.5f, nullptr, nullptr};
            pg8::gemm_phase<pg8::EpiRes<0>, pg8::StaticOrder, true, true>(lds, g, S, E); } SEAM(pb + 1);
        if (EN(2) && IN(pb + 2)) { FRESH(); WL(); pg8::Gemm g{XB, wl + W_IN, M, INC, D}; pg8::StaticOrder S; S.init(M, INC, G, (int)blockIdx.x); pg8::EpiZ E{HZ, SS1, CS};
            _Pragma("unroll 1") for (int rep = 0; rep < NREP(2); ++rep) { pg8::gemm_phase<pg8::EpiZ, pg8::StaticOrder, true, true>(lds, g, S, E); } } SEAM(pb + 2);
        if (EN(3) && IN(pb + 3)) { FRESH(); _Pragma("unroll 1") for (int rep = 0; rep < NREP(3); ++rep) { phase_m1(a, L, lds, tid, G, ws, outb); prep_transposes(a, lds, tid, G, ws, outb); } } SEAM(pb + 3);
        if (EN(4) && IN(pb + 4)) { FRESH(); _Pragma("unroll 1") for (int rep = 0; rep < NREP(4); ++rep) { ret_kv_phase(a, tid, G, ws, outb); moba_gate_phase(a, lds, tid, G, ws, outb); } } SEAM(pb + 4);
        if (EN(5) && IN(pb + 5)) { FRESH(); _Pragma("unroll 1") for (int rep = 0; rep < NREP(5); ++rep) { ret_scan_phase(a, tid, G, ws, outb); moba_past_phase(a, L, lds, tid, G, ws, outb); } } SEAM(pb + 5);
        if (EN(6) && IN(pb + 6)) { FRESH(); _Pragma("unroll 1") for (int rep = 0; rep < NREP(6); ++rep) { ret_out_phase(a, lds, tid, G, ws, outb); moba_own_phase(a, lds, tid, G, ws, outb); } } SEAM(pb + 6);
        if (EN(7) && IN(pb + 7)) { FRESH(); WL(); pg8::Gemm g{Y, wl + W_OUT, M, D, D}; pg8::StaticOrder S; S.init(M, D, G, (int)blockIdx.x); pg8::EpiRes<0> E{XB, XB, SS0, 1.0f, nullptr, nullptr};
            pg8::gemm_phase<pg8::EpiRes<0>, pg8::StaticOrder, true, true>(lds, g, S, E); } SEAM(pb + 7);
        if (EN(8) && IN(pb + 8)) { FRESH(); WL(); pg8::Gemm g{XB, wl + W_GU2, M, 2 * FF, D}; pg8::StaticOrder S; S.init(M, 2 * FF, G, (int)blockIdx.x); pg8::EpiGLU E{HZ, FF, SS0};
            _Pragma("unroll 1") for (int rep = 0; rep < NREP(0); ++rep) { pg8::gemm_phase<pg8::EpiGLU, pg8::StaticOrder, true, true>(lds, g, S, E); } }
        if (EN(8) && IN(pb + 8)) { FRESH(); WL(); pg8::Gemm g{(const bf16*)(ws + WS_PB) + (size_t)L * M * PLE, wl + W_PP, M, D, PLE}; pg8::StaticOrder S; S.init(M, D, G, (int)blockIdx.x); pg8::EpiPlain E{Y, D};
            _Pragma("unroll 1") for (int rep = 0; rep < NREP(8); ++rep) { pg8::gemm_phase<pg8::EpiPlain, pg8::StaticOrder, true, true>(lds, g, S, E); } } SEAM(pb + 8);
        if (EN(9) && IN(pb + 9)) { FRESH(); WL(); pg8::Gemm g{HZ, wl + W_D2, M, D, FF}; pg8::StaticOrder S; S.init(M, D, G, (int)blockIdx.x); pg8::EpiRes<0> E{XB, XB, SS1, 0.5f, nullptr, nullptr};
            pg8::gemm_phase<pg8::EpiRes<0>, pg8::StaticOrder, true, true>(lds, g, S, E); } SEAM(pb + 9);
        if (EN(10) && IN(pb + 10)) { FRESH(); WL(); pg8::Gemm g{XB, wl + W_PG, M, D, D}; pg8::StaticOrder S; S.init(M, D, G, (int)blockIdx.x); pg8::EpiRes<1> E{XB, (bf16*)(ws + WS_XB2), SS0, 1.0f, SS1, Y};
            pg8::gemm_phase<pg8::EpiRes<1>, pg8::StaticOrder, true, true>(lds, g, S, E); } SEAM(pb + 10);
    }
    if (EN(12) && IN(N_PHASES - 1)) phase_final(a, lane, wave, G);
#undef IN
#undef SEAM
}

extern "C" void kernel_launch(void* const* d_in, const int* in_sizes, int n_in, void* d_out, int out_size, void* d_ws, size_t ws_size, hipStream_t stream) {
    static int grid = 0;
    if (grid == 0) {
        if (n_in != 19 || out_size != M * D || ws_size < WS_END) { fprintf(stderr, "kernel_launch: unexpected shapes: n_in %d out %d ws %zu (need %zu)\n", n_in, out_size, ws_size, (size_t)WS_END); grid = -1; return; }
        int dev = 0, cus = 0, per_cu = 0;
        if (hipGetDevice(&dev) != hipSuccess || hipDeviceGetAttribute(&cus, hipDeviceAttributeMultiprocessorCount, dev) != hipSuccess) { grid = -1; return; }
        if (hipFuncSetAttribute((const void*)mega_fwd, hipFuncAttributeMaxDynamicSharedMemorySize, LDS_BYTES) != hipSuccess) { fprintf(stderr, "kernel_launch: hipFuncSetAttribute failed\n"); grid = -1; return; }
        if (hipOccupancyMaxActiveBlocksPerMultiprocessor(&per_cu, (const void*)mega_fwd, NTHR, LDS_BYTES) != hipSuccess || per_cu < 1) { fprintf(stderr, "kernel_launch: occupancy query says %d\n", per_cu); per_cu = 1; }
        (void)hipGetLastError();
        grid = cus;
    }
    if (grid < 0) return;
    Args a{};
    for (int i = 0; i < 19; ++i) a.in[i] = (const float*)d_in[i];
    a.out = (float*)d_out; a.ws = (unsigned char*)d_ws;
    for (int i = 0; i < 32; ++i) a.theta[i] = 1.0 / pow(10000.0, (double)i / 31.0);
    for (int h = 0; h < 4; ++h) a.lg2g[h] = (float)log2(1.0 - pow(2.0, -5.0 - (double)h));
    a.ph_lo = 0; a.ph_hi = N_PHASES;
    void* args[] = {&a};
    hipError_t e = hipLaunchCooperativeKernel((const void*)mega_fwd, dim3(grid), dim3(NTHR), args, LDS_BYTES, stream);
    if (e != hipSuccess) fprintf(stderr, "kernel_launch: cooperative launch failed: %s (grid %d)\n", hipGetErrorString(e), grid);
}
```

```cpp
#include <hip/hip_runtime.h>
#include <hip/hip_cooperative_groups.h>
#include <cstdio>
#include <cstdint>
#include <cmath>
namespace cg = cooperative_groups;
namespace pg8 {
#define PG8_LAS __attribute__((address_space(3)))
typedef unsigned short bf16_t;
typedef short bf16x8 __attribute__((ext_vector_type(8)));
typedef float f32x4 __attribute__((ext_vector_type(4)));
typedef unsigned u32x4 __attribute__((ext_vector_type(4)));
constexpr int BM = 256, BK = 64, HALF = 128, HTB = HALF * BK * 2  , STAGE_BYTES = 8 * HTB, NXCD = 8, WGM = 8;

__host__ __device__ __forceinline__ int lds_byte(int r, int c) { const int st = (r >> 4) * 2 + (c >> 5), rr = r & 15, cc = c & 31, ob = rr * 64 + cc * 2; return st * 1024 + (ob ^ (((ob >> 9) & 1) << 5)); }
__host__ __device__ __forceinline__ void stage_rc(int b, int& R, int& C) { const int st = b / 1024, sb = b % 1024, swz = sb ^ (((sb >> 9) & 1) << 5); R = (st >> 1) * 16 + swz / 64; C = (st & 1) * 32 + (swz % 64) / 2; }
__host__ __device__ __forceinline__ int perm32(int rho) { const int n = rho >> 4, i = rho & 15; return 8 * (i >> 2) + 4 * n + (i & 3); }

struct Unit { int pm, pn; };
struct Gemm { const bf16_t* A; const bf16_t* Bt; int M, N, K; };

struct StaticOrder {
    int nM, nN, nwg, G, c;
    __host__ __device__ void init(int M, int N, int G_, int c_) { nM = M / BM; nN = N / BM; nwg = nM * nN; G = G_; c = c_; }
    __host__ __device__ bool next(int i, Unit& u) const {
        const long L = (long)i * G + c; if (L >= nwg) return false;
        int wgid = (int)L; { const int q = nwg / NXCD, r = nwg % NXCD, xcd = wgid % NXCD, off = wgid / NXCD; wgid = (xcd < r ? xcd * (q + 1) : r * (q + 1) + (xcd - r) * q) + off; }
        const int nig = WGM * nN, gid = wgid / nig, fm = gid * WGM, gsz = (nM - fm) < WGM ? (nM - fm) : WGM;
        u.pm = fm + ((wgid % nig) % gsz); u.pn = (wgid % nig) / gsz; return true;
    }
    __device__ __forceinline__ void a_ready(const Unit&) const {}
    __device__ __forceinline__ void done(const Unit&) const {}
};

__device__ __forceinline__ unsigned cvt_pk_bf16(float lo, float hi) { unsigned r; asm volatile("v_cvt_pk_bf16_f32 %0, %1, %2" : "=v"(r) : "v"(lo), "v"(hi)); return r; }
__device__ __forceinline__ float quad_sum(float s) {
    { auto rr = __builtin_amdgcn_permlane16_swap(__float_as_uint(s), __float_as_uint(s), false, false); s = __uint_as_float(rr[0]) + __uint_as_float(rr[1]); }
    { auto rr = __builtin_amdgcn_permlane32_swap(__float_as_uint(s), __float_as_uint(s), false, false); s = __uint_as_float(rr[0]) + __uint_as_float(rr[1]); }
    return s;
}
__device__ __forceinline__ float row_rstd(const float* ssp, int row, int fq) {
    const f32x4 v = *(const f32x4*)(ssp + (size_t)row * 16 + fq * 4);
    float s = (v[0] + v[1]) + (v[2] + v[3]);
    s = quad_sum(s);
    return __builtin_amdgcn_rsqf(s * (1.0f / 1024.0f) + 1e-6f);
}
__device__ __forceinline__ float silu_f(float g) { return g * __builtin_amdgcn_rcpf(1.0f + __builtin_amdgcn_exp2f(-1.44269504089f * g)); }
__device__ __forceinline__ float sigm_f(float g) { return __builtin_amdgcn_rcpf(1.0f + __builtin_amdgcn_exp2f(-1.44269504089f * g)); }

struct EpiGLU {
    static constexpr bool PERM = true, AFTER_DRAIN = false;
    bf16_t* H; int ldh; const float* ssp;
    __device__ __forceinline__ void operator()(const f32x4 (&acc)[2][2][4][2], const Unit& u, int wr, int wc, int fr, int fq) const {
        const int row0 = u.pm * BM + wr * 64 + fr, col0 = u.pn * HALF + wc * 32 + 8 * fq;
#pragma unroll
        for (int ai = 0; ai < 2; ++ai)
#pragma unroll
            for (int m = 0; m < 4; ++m) {
                const int row = row0 + ai * HALF + m * 16; const float r = row_rstd(ssp, row, fq);
                const float rc = r * -1.44269504089f, r2 = r * r;
                const f32x4 ga = acc[ai][0][m][0], gb = acc[ai][0][m][1];
                const f32x4 pa = (ga * acc[ai][1][m][0]) * r2, pb = (gb * acc[ai][1][m][1]) * r2;
                const f32x4 ta = ga * rc, tb = gb * rc;
                f32x4 ha, hb;
#pragma unroll
                for (int k = 0; k < 4; ++k) { ha[k] = pa[k] * __builtin_amdgcn_rcpf(1.0f + __builtin_amdgcn_exp2f(ta[k])); hb[k] = pb[k] * __builtin_amdgcn_rcpf(1.0f + __builtin_amdgcn_exp2f(tb[k])); }
                u32x4 w; w.x = cvt_pk_bf16(ha[0], ha[1]); w.y = cvt_pk_bf16(ha[2], ha[3]); w.z = cvt_pk_bf16(hb[0], hb[1]); w.w = cvt_pk_bf16(hb[2], hb[3]);
                *(u32x4*)(H + (size_t)row * ldh + col0) = w;
            }
    }
};
__device__ __forceinline__ void unpack8(const u32x4 w, f32x4& a, f32x4& b) {
    a[0] = __uint_as_float(w.x << 16); a[1] = __uint_as_float(w.x & 0xffff0000u); a[2] = __uint_as_float(w.y << 16); a[3] = __uint_as_float(w.y & 0xffff0000u);
    b[0] = __uint_as_float(w.z << 16); b[1] = __uint_as_float(w.z & 0xffff0000u); b[2] = __uint_as_float(w.w << 16); b[3] = __uint_as_float(w.w & 0xffff0000u);
}
template <int MODE> struct EpiRes {
    static constexpr bool PERM = true, AFTER_DRAIN = false;
    const bf16_t* xin; bf16_t* xout; float* ssp_out; float alpha; const float* ssp_in; const bf16_t* PP;
    __device__ __forceinline__ void operator()(const f32x4 (&acc)[2][2][4][2], const Unit& u, int wr, int wc, int fr, int fq) const {
        const int row0 = u.pm * BM + wr * 64 + fr, col0 = u.pn * BM + wc * 32 + 8 * fq;
        constexpr int MB = (MODE == 1) ? 2 : 4;
#pragma unroll
        for (int ai = 0; ai < 2; ++ai)
#pragma unroll
        for (int mb = 0; mb < 4; mb += MB) {
            u32x4 xv[MB][2], pv[MB][2]; float r[MB];
#pragma unroll
            for (int mm = 0; mm < MB; ++mm) {
                const int m = mb + mm; const size_t off = (size_t)(row0 + ai * HALF + m * 16) * 1024 + col0;
                xv[mm][0] = *(const u32x4*)(xin + off); xv[mm][1] = *(const u32x4*)(xin + off + HALF);
                if (MODE == 1) { pv[mm][0] = *(const u32x4*)(PP + off); pv[mm][1] = *(const u32x4*)(PP + off + HALF); r[mm] = row_rstd(ssp_in, row0 + ai * HALF + m * 16, fq); }
            }
#pragma unroll
            for (int mm = 0; mm < MB; ++mm) {
                const int m = mb + mm; const int row = row0 + ai * HALF + m * 16; float ss = 0.f;
#pragma unroll
                for (int bj = 0; bj < 2; ++bj) {
                    f32x4 a, b, d0, d1; unpack8(xv[mm][bj], a, b);
                    if (MODE == 0) { d0 = acc[ai][bj][m][0] * alpha; d1 = acc[ai][bj][m][1] * alpha; }
                    else {
                        f32x4 p0, p1; unpack8(pv[mm][bj], p0, p1);
                        const f32x4 t0 = acc[ai][bj][m][0] * r[mm], t1 = acc[ai][bj][m][1] * r[mm];
#pragma unroll
                        for (int k = 0; k < 4; ++k) { d0[k] = sigm_f(t0[k]) * p0[k]; d1[k] = sigm_f(t1[k]) * p1[k]; }
                    }
                    a = a + d0; b = b + d1;
                    u32x4 w; w.x = cvt_pk_bf16(a[0], a[1]); w.y = cvt_pk_bf16(a[2], a[3]); w.z = cvt_pk_bf16(b[0], b[1]); w.w = cvt_pk_bf16(b[2], b[3]);
                    *(u32x4*)(xout + (size_t)row * 1024 + col0 + bj * HALF) = w;
                    unpack8(w, a, b);
                    ss += ((a[0] * a[0] + a[1] * a[1]) + (a[2] * a[2] + a[3] * a[3])) + ((b[0] * b[0] + b[1] * b[1]) + (b[2] * b[2] + b[3] * b[3]));
                }
                ss = quad_sum(ss);
                if (fq == 0) ssp_out[(size_t)row * 16 + u.pn * 4 + wc] = ss;
            }
        }
    }
};
struct EpiZ {
    static constexpr bool PERM = true, AFTER_DRAIN = false;
    bf16_t* Z; const float* ssp; const float* cs;
    __device__ __forceinline__ void operator()(const f32x4 (&acc)[2][2][4][2], const Unit& u, int wr, int wc, int fr, int fq) const {
        const int row0 = u.pm * BM + wr * 64 + fr, col0 = u.pn * BM + wc * 32 + 8 * fq;
        const bool rot = u.pn < 2; const float sc = (u.pn == 1 || u.pn == 7) ? 0.125f : 1.0f;
#pragma unroll
        for (int ai = 0; ai < 2; ++ai)
#pragma unroll
            for (int m = 0; m < 4; ++m) {
                const int row = row0 + ai * HALF + m * 16; const float r = row_rstd(ssp, row, fq) * sc;
#pragma unroll
                for (int bj = 0; bj < 2; ++bj) {
                    const int col = col0 + bj * HALF;
                    f32x4 a = acc[ai][bj][m][0] * r, b = acc[ai][bj][m][1] * r;
                    if (rot) {
                        const float* t = cs + ((size_t)(row & 8191) * 32 + ((col & 63) >> 1)) * 2;
                        const f32x4 t0 = *(const f32x4*)t, t1 = *(const f32x4*)(t + 4);
                        f32x4 a2, b2;
                        a2[0] = a[0] * t0[0] - a[1] * t0[1]; a2[1] = a[1] * t0[0] + a[0] * t0[1];
                        a2[2] = a[2] * t0[2] - a[3] * t0[3]; a2[3] = a[3] * t0[2] + a[2] * t0[3];
                        b2[0] = b[0] * t1[0] - b[1] * t1[1]; b2[1] = b[1] * t1[0] + b[0] * t1[1];
                        b2[2] = b[2] * t1[2] - b[3] * t1[3]; b2[3] = b[3] * t1[2] + b[2] * t1[3];
                        a = a2; b = b2;
                    }
                    u32x4 w; w.x = cvt_pk_bf16(a[0], a[1]); w.y = cvt_pk_bf16(a[2], a[3]); w.z = cvt_pk_bf16(b[0], b[1]); w.w = cvt_pk_bf16(b[2], b[3]);
                    *(u32x4*)(Z + (size_t)row * 2560 + col) = w;
                }
            }
    }
};
struct EpiPlain {
    static constexpr bool PERM = true, AFTER_DRAIN = false;
    bf16_t* O; int ldc;
    __device__ __forceinline__ void operator()(const f32x4 (&acc)[2][2][4][2], const Unit& u, int wr, int wc, int fr, int fq) const {
        const int row0 = u.pm * BM + wr * 64 + fr, col0 = u.pn * BM + wc * 32 + 8 * fq;
#pragma unroll
        for (int ai = 0; ai < 2; ++ai)
#pragma unroll
            for (int m = 0; m < 4; ++m)
#pragma unroll
                for (int bj = 0; bj < 2; ++bj) {
                    const f32x4 a = acc[ai][bj][m][0], b = acc[ai][bj][m][1];
                    u32x4 w; w.x = cvt_pk_bf16(a[0], a[1]); w.y = cvt_pk_bf16(a[2], a[3]); w.z = cvt_pk_bf16(b[0], b[1]); w.w = cvt_pk_bf16(b[2], b[3]);
                    *(u32x4*)(O + (size_t)(row0 + ai * HALF + m * 16) * ldc + col0 + bj * HALF) = w;
                }
    }
};

template <class Epi, class Sched, bool ALIGN_EPI = false, bool SP2 = false>
__device__ __forceinline__ void gemm_phase(PG8_LAS unsigned char* lds, const Gemm g, const Sched& S, const Epi& E) {
    int tid_l = threadIdx.x; asm volatile("" : "+v"(tid_l));
    const int tid = tid_l, wid = __builtin_amdgcn_readfirstlane(tid >> 6), lane = tid & 63, wr = wid >> 2, wc = wid & 3, fr = lane & 15, fq = lane >> 4;
    const int K = g.K, nt = K / BK;
    unsigned voffA[2], voffB[2];
#pragma unroll
    for (int i = 0; i < 2; ++i) { int R, C; stage_rc(tid * 16 + i * 8192, R, C); const int Rb = Epi::PERM ? ((R & ~31) + perm32(R & 31)) : R;
        voffA[i] = (unsigned)(R * K + C) * 2u; voffB[i] = (unsigned)(Rb * K + C) * 2u; }
    const size_t kstep = (size_t)(BK * 2);
    const size_t hstep = (size_t)HALF * K * 2;
    const size_t tstep = 2 * hstep;
    const unsigned ldsw = (unsigned)wid * 1024u;
    const int aoff = lds_byte(wr * 64 + fr, fq * 8), boff = lds_byte(wc * 32 + fr, fq * 8);
#define PG8_SA(b, h) (((b) * 2 + (h)) * HTB)
#define PG8_SB(b, h) ((4 + (b) * 2 + (h)) * HTB)
#define PG8_STAGE(bufoff, gbase, voff) do { _Pragma("unroll") for (int _i = 0; _i < 2; ++_i) \
        __builtin_amdgcn_global_load_lds((const unsigned*)((const char*)(gbase) + (voff)[_i]), (PG8_LAS unsigned*)(lds + (bufoff) + ldsw + _i * 8192), 16, 0, 0); } while (0)
#define PG8_LDA(dst, b, h) do { _Pragma("unroll") for (int m = 0; m < 4; ++m) _Pragma("unroll") for (int k = 0; k < 2; ++k) dst[m][k] = *(const PG8_LAS bf16x8*)(lds + PG8_SA(b, h) + aoff + m * 2048 + k * 1024); } while (0)
#define PG8_LDB(dst, b, h) do { _Pragma("unroll") for (int n = 0; n < 2; ++n) _Pragma("unroll") for (int k = 0; k < 2; ++k) dst[n][k] = *(const PG8_LAS bf16x8*)(lds + PG8_SB(b, h) + boff + n * 2048 + k * 1024); } while (0)
#define PG8_MMA(ai, bj, At, Bt) do { __builtin_amdgcn_s_setprio(1); _Pragma("unroll") for (int m = 0; m < 4; ++m) _Pragma("unroll") for (int n = 0; n < 2; ++n) _Pragma("unroll") for (int k = 0; k < 2; ++k) \
        acc[ai][bj][m][n] = __builtin_amdgcn_mfma_f32_16x16x32_bf16(Bt[n][k], At[m][k], acc[ai][bj][m][n], 0, 0, 0); __builtin_amdgcn_s_setprio(0); } while (0)
#define PG8_WAIT_V(n) asm volatile("s_waitcnt vmcnt(" #n ")" ::: "memory")
#define PG8_WAIT_L(n) asm volatile("s_waitcnt lgkmcnt(" #n ")" ::: "memory")
#define PG8_BAR __builtin_amdgcn_s_barrier()
#define PG8_SCHED __builtin_amdgcn_sched_barrier(0)
    Unit cur, nxt; int ui = 0;
    if (!S.next(0, cur)) return;
    f32x4 acc[2][2][4][2];
#pragma unroll
    for (int a = 0; a < 2; ++a)
#pragma unroll
        for (int b = 0; b < 2; ++b)
#pragma unroll
            for (int m = 0; m < 4; ++m)
#pragma unroll
                for (int n = 0; n < 2; ++n) acc[a][b][m][n] = (f32x4){0.f, 0.f, 0.f, 0.f};
    bf16x8 At[4][2], B0[2][2], B1[2][2];
    const char* cA = (const char*)g.A + (size_t)cur.pm * tstep; const char* cB = (const char*)g.Bt + (size_t)cur.pn * tstep;
    S.a_ready(cur);
    if constexpr (SP2) {
        PG8_STAGE(PG8_SB(0, 0), cB, voffB); PG8_STAGE(PG8_SB(0, 1), cB + hstep, voffB); PG8_STAGE(PG8_SA(0, 0), cA, voffA); PG8_STAGE(PG8_SA(0, 1), cA + hstep, voffA);
        if (wr == 1) PG8_BAR;
        PG8_WAIT_V(2); PG8_BAR;
        PG8_STAGE(PG8_SB(1, 0), cB + kstep, voffB); PG8_STAGE(PG8_SA(1, 0), cA + kstep, voffA); PG8_STAGE(PG8_SB(1, 1), cB + hstep + kstep, voffB);
        PG8_WAIT_V(6); PG8_BAR;
    } else {
        PG8_STAGE(PG8_SB(0, 0), cB, voffB); PG8_STAGE(PG8_SA(0, 0), cA, voffA); PG8_STAGE(PG8_SB(0, 1), cB + hstep, voffB); PG8_STAGE(PG8_SA(0, 1), cA + hstep, voffA);
        if (wr == 1) PG8_BAR;
        PG8_WAIT_V(4); PG8_BAR;
        PG8_STAGE(PG8_SB(1, 0), cB + kstep, voffB); PG8_STAGE(PG8_SA(1, 0), cA + kstep, voffA); PG8_STAGE(PG8_SB(1, 1), cB + hstep + kstep, voffB);
        PG8_WAIT_V(6); PG8_BAR;
    }
    for (;;) {
        const bool has_next = S.next(ui + 1, nxt);
        const char* nA = has_next ? (const char*)g.A + (size_t)nxt.pm * tstep : cA; const char* nB = has_next ? (const char*)g.Bt + (size_t)nxt.pn * tstep : cB;
#pragma unroll 1
        for (int t = 0; t < nt; t += 2) {
            const bool last = (t == nt - 2);
            const char* a1 = cA + (size_t)(t + 1) * kstep;
            const char* a2 = last ? nA : cA + (size_t)(t + 2) * kstep; const char* b2 = last ? nB : cB + (size_t)(t + 2) * kstep;
            const char* a3 = a2 + kstep; const char* b3 = b2 + kstep;
            if (last && has_next) S.a_ready(nxt);
            if constexpr (SP2) {
            PG8_LDB(B0, 0, 0); PG8_LDB(B1, 0, 1); PG8_SCHED; PG8_LDA(At, 0, 0); PG8_STAGE(PG8_SA(1, 1), a1 + hstep, voffA);
            PG8_WAIT_V(8); PG8_WAIT_L(0); PG8_BAR; PG8_MMA(0, 0, At, B0); PG8_MMA(0, 1, At, B1); PG8_BAR; PG8_SCHED;
            PG8_LDA(At, 0, 1); PG8_STAGE(PG8_SB(0, 0), b2, voffB); PG8_STAGE(PG8_SB(0, 1), b2 + hstep, voffB); PG8_STAGE(PG8_SA(0, 0), a2, voffA);
            PG8_WAIT_V(8); PG8_WAIT_L(0); PG8_BAR; PG8_MMA(1, 0, At, B0); PG8_MMA(1, 1, At, B1); PG8_BAR; PG8_SCHED;
            PG8_LDB(B0, 1, 0); PG8_LDB(B1, 1, 1); PG8_SCHED; PG8_LDA(At, 1, 0); PG8_STAGE(PG8_SA(0, 1), a2 + hstep, voffA);
            PG8_WAIT_V(8); PG8_WAIT_L(0); PG8_BAR; PG8_MMA(0, 0, At, B0); PG8_MMA(0, 1, At, B1); PG8_BAR; PG8_SCHED;
            PG8_LDA(At, 1, 1); PG8_STAGE(PG8_SB(1, 0), b3, voffB); PG8_STAGE(PG8_SB(1, 1), b3 + hstep, voffB); PG8_STAGE(PG8_SA(1, 0), a3, voffA);
            PG8_WAIT_V(8); PG8_WAIT_L(0); PG8_BAR; PG8_MMA(1, 0, At, B0); PG8_MMA(1, 1, At, B1); PG8_BAR; PG8_SCHED;
            } else {
            PG8_LDB(B0, 0, 0); PG8_SCHED; PG8_LDA(At, 0, 0); PG8_STAGE(PG8_SA(1, 1), a1 + hstep, voffA);
            PG8_WAIT_L(8); PG8_BAR; PG8_WAIT_L(0); PG8_MMA(0, 0, At, B0); PG8_BAR; PG8_SCHED;
            PG8_LDB(B1, 0, 1); PG8_STAGE(PG8_SB(0, 0), b2, voffB);
            PG8_BAR; PG8_WAIT_L(0); PG8_MMA(0, 1, At, B1); PG8_BAR;
            PG8_LDA(At, 0, 1); PG8_STAGE(PG8_SA(0, 0), a2, voffA);
            PG8_BAR; PG8_WAIT_L(0); PG8_MMA(1, 0, At, B0); PG8_BAR; PG8_SCHED;
            PG8_STAGE(PG8_SB(0, 1), b2 + hstep, voffB);
            PG8_WAIT_V(6); PG8_BAR; PG8_MMA(1, 1, At, B1); PG8_BAR;
            PG8_LDB(B0, 1, 0); PG8_SCHED; PG8_LDA(At, 1, 0); PG8_STAGE(PG8_SA(0, 1), a2 + hstep, voffA);
            PG8_WAIT_L(8); PG8_BAR; PG8_WAIT_L(0); PG8_MMA(0, 0, At, B0); PG8_BAR; PG8_SCHED;
            PG8_LDB(B1, 1, 1); PG8_STAGE(PG8_SB(1, 0), b3, voffB);
            PG8_BAR; PG8_WAIT_L(0); PG8_MMA(0, 1, At, B1); PG8_BAR;
            PG8_LDA(At, 1, 1); PG8_STAGE(PG8_SA(1, 0), a3, voffA);
            PG8_BAR; PG8_WAIT_L(0); PG8_MMA(1, 0, At, B0); PG8_BAR; PG8_SCHED;
            PG8_STAGE(PG8_SB(1, 1), b3 + hstep, voffB);
            PG8_WAIT_V(6); PG8_BAR; PG8_MMA(1, 1, At, B1); PG8_BAR;
            }
        }
        if constexpr (ALIGN_EPI) { if (wr == 0) PG8_BAR; }
        if constexpr (!Epi::AFTER_DRAIN) { E(acc, cur, wr, wc, fr, fq); S.done(cur); }
        if (!has_next) break;
#pragma unroll
        for (int a = 0; a < 2; ++a)
#pragma unroll
            for (int b = 0; b < 2; ++b)
#pragma unroll
                for (int m = 0; m < 4; ++m)
#pragma unroll
                    for (int n = 0; n < 2; ++n) acc[a][b][m][n] = (f32x4){0.f, 0.f, 0.f, 0.f};
        cur = nxt; cA = nA; cB = nB; ++ui;
        if constexpr (ALIGN_EPI) { if (wr == 1) PG8_BAR; }
    }
    PG8_WAIT_V(0);
    if constexpr (!ALIGN_EPI) { if (wr == 0) PG8_BAR; }
    PG8_BAR;
    if constexpr (Epi::AFTER_DRAIN) { E.fused(acc, cur, wr, wc, fr, fq, lds, wid, lane); S.done(cur); }
#undef PG8_SA
#undef PG8_SB
#undef PG8_STAGE
#undef PG8_LDA
#undef PG8_LDB
#undef PG8_MMA
#undef PG8_WAIT_V
#undef PG8_WAIT_L
#undef PG8_BAR
#undef PG8_SCHED
}
}

#define LAS __attribute__((address_space(3)))
typedef unsigned short bf16;
typedef float f32x4 __attribute__((ext_vector_type(4)));
typedef unsigned u32x4 __attribute__((ext_vector_type(4)));
typedef unsigned u32x2 __attribute__((ext_vector_type(2)));

constexpr int NWAVES = 8, NTHR = 512;
constexpr int BATCH = 8, SEQ = 8192, D = 1024, FF = 2816, INC = 2560, PLE = 256, DEPTH = 2;
constexpr int M = BATCH * SEQ;
constexpr int ZQ = 0, ZK = 256, ZV = 512, ZG = 1024, ZP = 1536, ZMQ = 1792, ZMK = 2048, ZMV = 2304;
constexpr size_t MiB = 1u << 20;
constexpr size_t WS_CS = 1 * MiB, WS_SS0 = 3 * MiB, WS_SS1 = 7 * MiB, WS_KMEAN = 11 * MiB, WS_W = 12 * MiB;
constexpr size_t W_GU1 = 0, W_D1 = W_GU1 + (size_t)2 * FF * D, W_IN = W_D1 + (size_t)D * FF, W_OUT = W_IN + (size_t)INC * D, W_GU2 = W_OUT + (size_t)D * D,
                 W_D2 = W_GU2 + (size_t)2 * FF * D, W_PG = W_D2 + (size_t)D * FF, W_PP = W_PG + (size_t)D * D, W_LAYER = W_PP + (size_t)D * PLE;
static_assert(WS_W + 2 * W_LAYER * 2 <= 100 * MiB, "weights");
constexpr size_t WS_XB = 100 * MiB, WS_HZ = 228 * MiB, WS_Y = 580 * MiB, WS_PB = 708 * MiB, WS_KV = 772 * MiB, WS_RS = 804 * MiB, WS_XB2 = 836 * MiB, WS_END = 964 * MiB;
static_assert((size_t)M * FF * 2 == 352 * MiB && (size_t)M * D * 2 == 128 * MiB, "sizes");
constexpr int LDS_BYTES = 147456;

__device__ __forceinline__ unsigned f2bf(float f) { unsigned u = __builtin_bit_cast(unsigned, f); return (u + 0x7fffu + ((u >> 16) & 1u)) >> 16; }
__device__ __forceinline__ unsigned pk2(float lo, float hi) { return pg8::cvt_pk_bf16(lo, hi); }
__device__ __forceinline__ float bflo(unsigned w) { return __uint_as_float(w << 16); }
__device__ __forceinline__ float bfhi(unsigned w) { return __uint_as_float(w & 0xffff0000u); }
__device__ __forceinline__ float bf1(bf16 h) { return __uint_as_float((unsigned)h << 16); }
__device__ __forceinline__ float wave_sum(float v) {
#pragma unroll
    for (int o = 1; o < 64; o <<= 1) v += __shfl_xor(v, o);
    return v;
}
#define LDS_WAIT() asm volatile("s_waitcnt lgkmcnt(0)" ::: "memory")

struct Args {
    const float* in[19]; float* out; unsigned char* ws;
    double theta[32]; float lg2g[4];
    int ph_lo, ph_hi;
};

__device__ __forceinline__ void transpose_item(const float* W, int K, int N, const float* gain, bf16* WT, int k0, int n0, int row_off, LAS float* scr, int lane) {
#pragma unroll 8
    for (int i = 0; i < 32; ++i) { const int kk = 2 * i + (lane >> 5); float v = W[(size_t)(k0 + kk) * N + n0 + (lane & 31)]; if (gain) v *= gain[k0 + kk]; scr[kk * 33 + (lane & 31)] = v; }
    LDS_WAIT(); asm volatile("" ::: "memory");
    const int c = lane & 7;
#pragma unroll
    for (int j = 0; j < 4; ++j) { const int n = (lane >> 3) + 8 * j; const LAS float* s = scr + (8 * c) * 33 + n;
        u32x4 o; o.x = pk2(s[0 * 33], s[1 * 33]); o.y = pk2(s[2 * 33], s[3 * 33]); o.z = pk2(s[4 * 33], s[5 * 33]); o.w = pk2(s[6 * 33], s[7 * 33]);
        *(u32x4*)(WT + (size_t)(row_off + n) * K + k0 + 8 * c) = o; }
    LDS_WAIT(); asm volatile("" ::: "memory");
}
__device__ __forceinline__ void tr_plain(const float* W, int K, int N, const float* gain, bf16* WT, int it, LAS float* scr, int lane) {
    const int nblk = N / 32, kb = it / nblk, nb = it % nblk; transpose_item(W, K, N, gain, WT, 64 * kb, 32 * nb, 32 * nb, scr, lane);
}
__device__ __forceinline__ void tr_glu(const float* W, const float* gain, bf16* WT, int up, int it, LAS float* scr, int lane) {
    const int nblk = FF / 32, kb = it / nblk, nb = it % nblk, n0 = 32 * nb; transpose_item(W, D, FF, gain, WT, 64 * kb, n0, (n0 >> 7) * 256 + (n0 & 127) + up * 128, scr, lane);
}

__device__ __forceinline__ void sincos_d(double x, float& c, float& s) {
    const double TWO_PI = 6.283185307179586476925286766559;
    const double n = rint(x / TWO_PI); const double r = x - n * TWO_PI, r2 = r * r;
    double ss = 1.0, cc = 1.0;
#pragma unroll
    for (int k = 15; k >= 1; --k) { ss = 1.0 - r2 * (1.0 / (double)((2 * k) * (2 * k + 1))) * ss; cc = 1.0 - r2 * (1.0 / (double)((2 * k - 1) * (2 * k))) * cc; }
    s = (float)(r * ss); c = (float)cc;
}

__device__ __forceinline__ void phase_prologue(const Args& a, LAS unsigned char* lds, int tid, int lane, int wave, int G) {
    unsigned char* ws = a.ws;
    LAS float* scr = (LAS float*)(lds + wave * 16384);
    const int gw = blockIdx.x * NWAVES + wave, NGW = G * NWAVES;
    constexpr int I_GU = (D / 64) * (FF / 32), I_DN = (FF / 64) * (D / 32), I_IN = (D / 64) * (INC / 32), I_SQ = (D / 64) * (D / 32), I_PP = (PLE / 64) * (D / 32);
    constexpr int I_LAYER = 4 * I_GU + 2 * I_DN + I_IN + 2 * I_SQ + I_PP;
    for (int it = gw; it < DEPTH * I_LAYER; it += NGW) {
        const int L = it / I_LAYER; int r = it % I_LAYER;
        bf16* wl = (bf16*)(ws + WS_W) + (size_t)L * W_LAYER;
        const float* n1 = a.in[2] + L * D; const float* nm = a.in[6] + L * D; const float* n2 = a.in[11] + L * D; const float* np = a.in[15] + L * D;
        if (r < I_GU) { tr_glu(a.in[3] + (size_t)L * D * FF, n1, wl + W_GU1, 0, r, scr, lane); continue; } r -= I_GU;
        if (r < I_GU) { tr_glu(a.in[4] + (size_t)L * D * FF, n1, wl + W_GU1, 1, r, scr, lane); continue; } r -= I_GU;
        if (r < I_DN) { tr_plain(a.in[5] + (size_t)L * FF * D, FF, D, nullptr, wl + W_D1, r, scr, lane); continue; } r -= I_DN;
        if (r < I_IN) { tr_plain(a.in[7] + (size_t)L * D * INC, D, INC, nm, wl + W_IN, r, scr, lane); continue; } r -= I_IN;
        if (r < I_SQ) { tr_plain(a.in[10] + (size_t)L * D * D, D, D, nullptr, wl + W_OUT, r, scr, lane); continue; } r -= I_SQ;
        if (r < I_GU) { tr_glu(a.in[12] + (size_t)L * D * FF, n2, wl + W_GU2, 0, r, scr, lane); continue; } r -= I_GU;
        if (r < I_GU) { tr_glu(a.in[13] + (size_t)L * D * FF, n2, wl + W_GU2, 1, r, scr, lane); continue; } r -= I_GU;
        if (r < I_DN) { tr_plain(a.in[14] + (size_t)L * FF * D, FF, D, nullptr, wl + W_D2, r, scr, lane); continue; } r -= I_DN;
        if (r < I_SQ) { tr_plain(a.in[16] + (size_t)L * D * D, D, D, np, wl + W_PG, r, scr, lane); continue; } r -= I_SQ;
        tr_plain(a.in[17] + (size_t)L * PLE * D, PLE, D, nullptr, wl + W_PP, r, scr, lane);
    }
    {
        const float* x = a.in[0]; bf16* xb = (bf16*)(ws + WS_XB2); float* ss = (float*)(ws + WS_SS0);
        for (int m = gw; m < M; m += NGW) {
            const f32x4* xr = (const f32x4*)(x + (size_t)m * D) + lane; u32x2* brow = (u32x2*)(xb + (size_t)m * D) + lane;
            float s = 0.f;
#pragma unroll
            for (int j = 0; j < 4; ++j) { const f32x4 v = xr[64 * j]; u32x2 w; w.x = pk2(v[0], v[1]); w.y = pk2(v[2], v[3]); brow[64 * j] = w;
                const float r0 = bflo(w.x), r1 = bfhi(w.x), r2 = bflo(w.y), r3 = bfhi(w.y); s += (r0 * r0 + r1 * r1) + (r2 * r2 + r3 * r3); }
            s = wave_sum(s);
            if (lane < 16) ss[(size_t)m * 16 + lane] = (lane == 0) ? s : 0.f;
        }
    }
    {
        const f32x4* p = (const f32x4*)a.in[1]; u32x2* pb = (u32x2*)(ws + WS_PB);
        const size_t n4 = (size_t)DEPTH * M * PLE / 4;
        for (size_t i = (size_t)blockIdx.x * NTHR + tid; i < n4; i += (size_t)G * NTHR) { const f32x4 v = p[i]; u32x2 w; w.x = pk2(v[0], v[1]); w.y = pk2(v[2], v[3]); pb[i] = w; }
    }
    {
        float* cs = (float*)(ws + WS_CS);
        for (int i = blockIdx.x * NTHR + tid; i < SEQ * 32; i += G * NTHR) { const int pos = i >> 5, k = i & 31; float c, s; sincos_d((double)pos * a.theta[k], c, s); cs[2 * i] = c; cs[2 * i + 1] = s; }
    }
}


typedef float f32x16 __attribute__((ext_vector_type(16)));
typedef short bf16x8 __attribute__((ext_vector_type(8)));
#define MFMA32(a, b, c) __builtin_amdgcn_mfma_f32_32x32x16_bf16((a), (b), (c), 0, 0, 0)
constexpr size_t OUT_VTM = 0, OUT_VTR = 32 * MiB, OUT_KTZ = 96 * MiB;
__device__ __forceinline__ int crow(int i, int hh) { return (i & 3) + 8 * (i >> 2) + 4 * hh; }

__device__ __forceinline__ void prep_transposes(const Args& a, LAS unsigned char* lds, int tid, int G, unsigned char* ws_, unsigned char* outb_) {
    unsigned char* ws = ws_; unsigned char* outb = outb_; (void)outb; const bf16* Z = (const bf16*)(ws + WS_HZ);
    LAS unsigned* T = (LAS unsigned*)lds;
    const int lane = tid & 63, w = tid >> 6;
    for (int it = blockIdx.x; it < BATCH * 32 * 5; it += G) {
        const int kind = it % 5, blk = (it / 5) & 31, b = it / 160;
        const int src = kind == 0 ? ZMV : (kind == 1 ? ZV : (kind == 2 ? ZV + 256 : (kind == 3 ? ZK : ZMK)));
        bf16* dst = kind == 0 ? (bf16*)(outb + OUT_VTM) + (size_t)b * 256 * SEQ : (kind == 3 ? (bf16*)(outb + OUT_KTZ) + (size_t)b * 256 * SEQ : (bf16*)(outb + OUT_VTR) + ((size_t)b * 512 + (kind == 2 ? 256 : 0)) * SEQ);
        __syncthreads();
        for (int c = tid; c < 256 * 32; c += NTHR) { const int r = c >> 5, cc = c & 31; const u32x4 v = *(const u32x4*)(Z + ((size_t)b * SEQ + blk * 256 + r) * INC + src + cc * 8);
            LAS unsigned* t = T + r * 129 + cc * 4; t[0] = v.x; t[1] = v.y; t[2] = v.z; t[3] = v.w; }
        __syncthreads();
        if (kind == 4) {
            if (tid < 256) { const LAS bf16* tp = (const LAS bf16*)T + tid; float s = 0.f;
#pragma unroll 8
                for (int r = 0; r < 256; ++r) s += bf1(tp[r * 258]);
                ((float*)(ws + WS_KMEAN))[((size_t)(b * 4 + (tid >> 6)) * 32 + blk) * 64 + (tid & 63)] = s * (1.0f / 256.0f); }
            continue;
        }
#pragma unroll 1
        for (int q = 0; q < 16; ++q) {
            const int Tq = w * 16 + q, c = (Tq & 7) * 32 + (lane & 31), pg = (Tq >> 3) * 2 + (lane >> 5);
            const int kbase = 16 * (pg >> 1) + 4 * (pg & 1);
            const LAS bf16* tp = (const LAS bf16*)T + c;
            float v[8];
#pragma unroll
            for (int j = 0; j < 8; ++j) { const int key = kbase + (j & 3) + 8 * (j >> 2); v[j] = bf1(tp[key * 258]); }
            if (kind == 3) { const float lg = a.lg2g[c >> 6];
#pragma unroll
                for (int j = 0; j < 8; ++j) { const int key = kbase + (j & 3) + 8 * (j >> 2); v[j] *= __builtin_amdgcn_exp2f(lg * (float)(255 - key)); } }
            u32x4 o; o.x = pk2(v[0], v[1]); o.y = pk2(v[2], v[3]); o.z = pk2(v[4], v[5]); o.w = pk2(v[6], v[7]);
            *(u32x4*)(dst + (size_t)c * SEQ + blk * 256 + pg * 8) = o;
        }
    }
    __syncthreads();
}

constexpr int MB_KROW = 144, MB_VROW = 528, MB_KBYTES = 256 * MB_KROW, MB_STAGE = MB_KBYTES + 64 * MB_VROW;
constexpr int MB_LIST = MB_STAGE, MB_MISC = MB_STAGE + 16384;
static_assert(MB_MISC + 64 <= LDS_BYTES - 64, "moba lds");
constexpr size_t OUT_PO = 128 * MiB, OUT_PM = 224 * MiB, OUT_SEL = 232 * MiB;
constexpr int CTR_WORD0 = 3584;

__device__ __forceinline__ void moba_tile(const LAS unsigned char* Kb, const LAS unsigned char* Vb, int t, const bf16x8 (&qf)[4], f32x16& O0, f32x16& O1, float& mx, float& l, bool diag, int qpos, int ql, int hh) {
    const float C = 1.44269504089f;
    f32x16 s0, s1;
#pragma unroll
    for (int i = 0; i < 16; ++i) { s0[i] = 0.f; s1[i] = 0.f; }
#pragma unroll
    for (int ks = 0; ks < 4; ++ks) {
        const bf16x8 a0 = *(const LAS bf16x8*)(Kb + (64 * t + ql) * MB_KROW + (16 * ks + 8 * hh) * 2);
        const bf16x8 a1 = *(const LAS bf16x8*)(Kb + (64 * t + 32 + ql) * MB_KROW + (16 * ks + 8 * hh) * 2);
        s0 = MFMA32(a0, qf[ks], s0); s1 = MFMA32(a1, qf[ks], s1);
    }
    if (diag) {
#pragma unroll
        for (int i = 0; i < 16; ++i) { const int kl = 64 * t + crow(i, hh); if (kl > qpos) s0[i] = -INFINITY; if (kl + 32 > qpos) s1[i] = -INFINITY; }
    }
    float tmax = fmaxf(s0[0], s1[0]);
#pragma unroll
    for (int i = 1; i < 16; ++i) tmax = fmaxf(tmax, fmaxf(s0[i], s1[i]));
    tmax = fmaxf(tmax, __shfl_xor(tmax, 32));
    const float mxn = fmaxf(mx, tmax);
    const float alpha = __builtin_amdgcn_exp2f((mx - mxn) * C);
    const float mref = mxn * C;
    mx = mxn;
    float ls = 0.f;
#pragma unroll
    for (int i = 0; i < 16; ++i) { s0[i] = __builtin_amdgcn_exp2f(s0[i] * C - mref); s1[i] = __builtin_amdgcn_exp2f(s1[i] * C - mref); ls += s0[i] + s1[i]; }
    l = l * alpha + ls;
    if (__ballot(alpha != 1.0f) != 0ull) {
#pragma unroll
        for (int i = 0; i < 16; ++i) { O0[i] *= alpha; O1[i] *= alpha; }
    }
#pragma unroll
    for (int sb = 0; sb < 2; ++sb)
#pragma unroll
        for (int s2 = 0; s2 < 2; ++s2) {
            union { u32x4 u; bf16x8 v; } pb;
            if (sb == 0) { pb.u.x = pk2(s0[8 * s2], s0[8 * s2 + 1]); pb.u.y = pk2(s0[8 * s2 + 2], s0[8 * s2 + 3]); pb.u.z = pk2(s0[8 * s2 + 4], s0[8 * s2 + 5]); pb.u.w = pk2(s0[8 * s2 + 6], s0[8 * s2 + 7]); }
            else         { pb.u.x = pk2(s1[8 * s2], s1[8 * s2 + 1]); pb.u.y = pk2(s1[8 * s2 + 2], s1[8 * s2 + 3]); pb.u.z = pk2(s1[8 * s2 + 4], s1[8 * s2 + 5]); pb.u.w = pk2(s1[8 * s2 + 6], s1[8 * s2 + 7]); }
            const int kp = 64 * t + 32 * sb + 16 * s2 + 8 * hh;
            const bf16x8 v0 = *(const LAS bf16x8*)(Vb + ql * MB_VROW + kp * 2);
            const bf16x8 v1 = *(const LAS bf16x8*)(Vb + (32 + ql) * MB_VROW + kp * 2);
            O0 = MFMA32(v0, pb.v, O0); O1 = MFMA32(v1, pb.v, O1);
        }
}

#define MB_SOFT(s0, s1, mx, l, O0, O1) do { \
    float tmax_ = fmaxf(s0[0], s1[0]); _Pragma("unroll") for (int i = 1; i < 16; ++i) tmax_ = fmaxf(tmax_, fmaxf(s0[i], s1[i])); \
    tmax_ = fmaxf(tmax_, __shfl_xor(tmax_, 32)); const float mxn_ = fmaxf(mx, tmax_); const float alpha_ = __builtin_amdgcn_exp2f((mx - mxn_) * C); const float mref_ = mxn_ * C; mx = mxn_; \
    float ls_ = 0.f; _Pragma("unroll") for (int i = 0; i < 16; ++i) { s0[i] = __builtin_amdgcn_exp2f(s0[i] * C - mref_); s1[i] = __builtin_amdgcn_exp2f(s1[i] * C - mref_); ls_ += s0[i] + s1[i]; } \
    l = l * alpha_ + ls_; if (__ballot(alpha_ != 1.0f) != 0ull) { _Pragma("unroll") for (int i = 0; i < 16; ++i) { O0[i] *= alpha_; O1[i] *= alpha_; } } } while (0)
#define MB_PACK(dst, s, s2) do { dst.u.x = pk2(s[8 * (s2)], s[8 * (s2) + 1]); dst.u.y = pk2(s[8 * (s2) + 2], s[8 * (s2) + 3]); dst.u.z = pk2(s[8 * (s2) + 4], s[8 * (s2) + 5]); dst.u.w = pk2(s[8 * (s2) + 6], s[8 * (s2) + 7]); } while (0)
__device__ __forceinline__ void moba_tile2(const LAS unsigned char* Kb, const LAS unsigned char* Vb, int t, const bf16x8 (&qa)[4], const bf16x8 (&qb)[4],
                                           f32x16& A0, f32x16& A1, f32x16& B0, f32x16& B1, float& mxa, float& la, float& mxb, float& lb, int ql, int hh) {
    const float C = 1.44269504089f;
    f32x16 sa0, sa1, sb0, sb1;
#pragma unroll
    for (int i = 0; i < 16; ++i) { sa0[i] = 0.f; sa1[i] = 0.f; sb0[i] = 0.f; sb1[i] = 0.f; }
#pragma unroll
    for (int ks = 0; ks < 4; ++ks) {
        const bf16x8 a0 = *(const LAS bf16x8*)(Kb + (64 * t + ql) * MB_KROW + (16 * ks + 8 * hh) * 2);
        const bf16x8 a1 = *(const LAS bf16x8*)(Kb + (64 * t + 32 + ql) * MB_KROW + (16 * ks + 8 * hh) * 2);
        sa0 = MFMA32(a0, qa[ks], sa0); sa1 = MFMA32(a1, qa[ks], sa1); sb0 = MFMA32(a0, qb[ks], sb0); sb1 = MFMA32(a1, qb[ks], sb1);
    }
    MB_SOFT(sa0, sa1, mxa, la, A0, A1);
    MB_SOFT(sb0, sb1, mxb, lb, B0, B1);
#pragma unroll
    for (int sb = 0; sb < 2; ++sb)
#pragma unroll
        for (int s2 = 0; s2 < 2; ++s2) {
            union { u32x4 u; bf16x8 v; } pa, pb;
            if (sb == 0) { MB_PACK(pa, sa0, s2); MB_PACK(pb, sb0, s2); } else { MB_PACK(pa, sa1, s2); MB_PACK(pb, sb1, s2); }
            const int kp = 64 * t + 32 * sb + 16 * s2 + 8 * hh;
            const bf16x8 v0 = *(const LAS bf16x8*)(Vb + ql * MB_VROW + kp * 2);
            const bf16x8 v1 = *(const LAS bf16x8*)(Vb + (32 + ql) * MB_VROW + kp * 2);
            A0 = MFMA32(v0, pa.v, A0); A1 = MFMA32(v1, pa.v, A1); B0 = MFMA32(v0, pb.v, B0); B1 = MFMA32(v1, pb.v, B1);
        }
}
__device__ __forceinline__ void moba_put_partial(bf16* PO, float* PM, size_t pidx, const f32x16& O0, const f32x16& O1, float mx, float l, int hh) {
    const float inv = 1.0f / l;
    bf16* po = PO + pidx * 64 + 4 * hh;
#pragma unroll
    for (int i4 = 0; i4 < 4; ++i4) {
        u32x2 o0, o1;
        o0.x = pk2(O0[4 * i4] * inv, O0[4 * i4 + 1] * inv); o0.y = pk2(O0[4 * i4 + 2] * inv, O0[4 * i4 + 3] * inv);
        o1.x = pk2(O1[4 * i4] * inv, O1[4 * i4 + 1] * inv); o1.y = pk2(O1[4 * i4 + 2] * inv, O1[4 * i4 + 3] * inv);
        *(u32x2*)(po + 8 * i4) = o0; *(u32x2*)(po + 32 + 8 * i4) = o1;
    }
    if (hh == 0) { PM[pidx * 2] = mx; PM[pidx * 2 + 1] = l; }
}
#define MB_STAGE_LOAD(Kg, Vg, m) u32x4 sk_[4], sv_[4]; _Pragma("unroll") for (int c = 0; c < 4; ++c) { const int ch = tl + NTHR * c; \
        sk_[c] = *(const u32x4*)((Kg) + (size_t)((m) * 256 + (ch >> 3)) * INC + (ch & 7) * 8); sv_[c] = *(const u32x4*)((Vg) + (size_t)(ch >> 5) * SEQ + (m) * 256 + (ch & 31) * 8); }
#define MB_STAGE_STORE() do { _Pragma("unroll") for (int c = 0; c < 4; ++c) { const int ch = tl + NTHR * c; *(LAS u32x4*)(lds + (ch >> 3) * MB_KROW + (ch & 7) * 16) = sk_[c]; *(LAS u32x4*)(lds + MB_KBYTES + (ch >> 5) * MB_VROW + (ch & 31) * 16) = sv_[c]; } } while (0)

__device__ __forceinline__ void moba_gate_phase(const Args& a, LAS unsigned char* lds, int tid, int G, unsigned char* ws_, unsigned char* outb_) {
    unsigned char* ws = ws_; unsigned char* outb = outb_; (void)outb; const bf16* Z = (const bf16*)(ws + WS_HZ); const float* km = (const float*)(ws + WS_KMEAN); unsigned* SEL = (unsigned*)(outb + OUT_SEL);
    const int lane = tid & 63, w = tid >> 6, ql = lane & 31, hh = lane >> 5;
    for (int e = blockIdx.x; e < BATCH * 4 * 32; e += G) {
        const int bh = e & 31, n = e >> 5, b = bh >> 2, h = bh & 3;
        const size_t rowq = (size_t)b * SEQ + n * 256 + w * 32 + ql;
        unsigned* selp = SEL + (size_t)bh * SEQ + n * 256 + w * 32 + ql;
        if (n == 0) { if (hh == 0) *selp = 0xFFFFFFu; continue; }
        __syncthreads();
        { const f32x4 v = *(const f32x4*)(km + (size_t)bh * 2048 + tid * 4); *(LAS f32x4*)(lds + tid * 16) = v; }
        float q[64];
        { const u32x4* qp = (const u32x4*)(Z + rowq * INC + ZMQ + h * 64);
#pragma unroll
          for (int c = 0; c < 8; ++c) { const u32x4 wv = qp[c]; q[8 * c] = bflo(wv.x); q[8 * c + 1] = bfhi(wv.x); q[8 * c + 2] = bflo(wv.y); q[8 * c + 3] = bfhi(wv.y); q[8 * c + 4] = bflo(wv.z); q[8 * c + 5] = bfhi(wv.z); q[8 * c + 6] = bflo(wv.w); q[8 * c + 7] = bfhi(wv.w); } }
        __syncthreads();
        float g0 = -INFINITY, g1 = -INFINITY, g2 = -INFINITY; int i0 = 255, i1 = 255, i2 = 255;
#define MB_INS(g, m) do { if ((g) > g0 || ((g) == g0 && (m) < i0)) { g2 = g1; i2 = i1; g1 = g0; i1 = i0; g0 = (g); i0 = (m); } \
        else if ((g) > g1 || ((g) == g1 && (m) < i1)) { g2 = g1; i2 = i1; g1 = (g); i1 = (m); } \
        else if ((g) > g2 || ((g) == g2 && (m) < i2)) { g2 = (g); i2 = (m); } } while (0)
        const int mend = (n < 16 * hh + 16) ? n : 16 * hh + 16;
        for (int m = 16 * hh; m < mend; ++m) {
            const LAS f32x4* kp = (const LAS f32x4*)(lds + m * 256);
            float g = 0.f;
#pragma unroll
            for (int c = 0; c < 16; ++c) { const f32x4 kv = kp[c]; g += q[4 * c] * kv[0] + q[4 * c + 1] * kv[1] + q[4 * c + 2] * kv[2] + q[4 * c + 3] * kv[3]; }
            MB_INS(g, m);
        }
        const float pg0 = __shfl_xor(g0, 32), pg1 = __shfl_xor(g1, 32), pg2 = __shfl_xor(g2, 32);
        const int pi0 = __shfl_xor(i0, 32), pi1 = __shfl_xor(i1, 32), pi2 = __shfl_xor(i2, 32);
        if (pi0 < 255) MB_INS(pg0, pi0);
        if (pi1 < 255) MB_INS(pg1, pi1);
        if (pi2 < 255) MB_INS(pg2, pi2);
#undef MB_INS
        if (hh == 0) *selp = (unsigned)i0 | ((unsigned)i1 << 8) | ((unsigned)i2 << 16);
    }
    __syncthreads();
}

__device__ __forceinline__ void moba_past_phase(const Args& a, int L, LAS unsigned char* lds, int tid, int G, unsigned char* ws_, unsigned char* outb_) {
    unsigned char* ws = ws_; unsigned char* outb = outb_; (void)outb; const bf16* Z = (const bf16*)(ws + WS_HZ); const bf16* VTM = (const bf16*)((const unsigned char*)outb + OUT_VTM);
    const unsigned* SEL = (const unsigned*)((const unsigned char*)outb + OUT_SEL); bf16* PO = (bf16*)(outb + OUT_PO); float* PM = (float*)(outb + OUT_PM);
    unsigned* ctr = (unsigned*)ws + CTR_WORD0 + 64 * L;
    const int lane = tid & 63, w = tid >> 6, ql = lane & 31, hh = lane >> 5;
    LAS unsigned short* list = (LAS unsigned short*)(lds + MB_LIST); LAS unsigned* misc = (LAS unsigned*)(lds + MB_MISC);
    for (;;) {
        __syncthreads();
        if (tid == 0) { misc[0] = __hip_atomic_fetch_add(ctr, 1u, __ATOMIC_RELAXED, __HIP_MEMORY_SCOPE_AGENT); misc[1] = 0u; }
        __syncthreads();
        const int e = (int)misc[0];
        if (e >= 31 * 32) break;
        const int m = e >> 5, bh = e & 31, b = bh >> 2, h = bh & 3;
        int tl = tid; asm volatile("" : "+v"(tl));
        const bf16* Kg = Z + (size_t)b * SEQ * INC + ZMK + h * 64; const bf16* Vg = VTM + ((size_t)b * 256 + h * 64) * SEQ;
        MB_STAGE_LOAD(Kg, Vg, m);
        for (int s0 = (m + 1) * 256 + tl; s0 < SEQ; s0 += 4 * NTHR) {
            unsigned sv4[4];
#pragma unroll
            for (int u = 0; u < 4; ++u) { const int s = s0 + u * NTHR; sv4[u] = (s < SEQ) ? SEL[(size_t)bh * SEQ + s] : 0xFFFFFFu; }
#pragma unroll
            for (int u = 0; u < 4; ++u) { const int s = s0 + u * NTHR; const unsigned sel = sv4[u];
#pragma unroll
                for (int t = 0; t < 3; ++t) if (((sel >> (8 * t)) & 0xFFu) == (unsigned)m) { const unsigned pos = __hip_atomic_fetch_add((unsigned*)(misc + 1), 1u, __ATOMIC_RELAXED, __HIP_MEMORY_SCOPE_WORKGROUP); list[pos] = (unsigned short)(s | (t << 13)); } }
        }
        MB_STAGE_STORE();
        __syncthreads();
        const int cnt = (int)misc[1];
        for (int c0 = 0; c0 < cnt; c0 += 512) {
            const int ia = c0 + w * 64 + ql, ib = ia + 32;
            if (c0 + w * 64 >= cnt) continue;
            const bool va = ia < cnt, vb = ib < cnt, two = (c0 + w * 64 + 32) < cnt;
            const unsigned ea = list[va ? ia : cnt - 1], eb = list[vb ? ib : cnt - 1];
            bf16x8 qa[4], qb[4];
#pragma unroll
            for (int ks = 0; ks < 4; ++ks) { qa[ks] = *(const bf16x8*)(Z + ((size_t)b * SEQ + (ea & 8191)) * INC + ZMQ + h * 64 + ks * 16 + hh * 8);
                                             qb[ks] = *(const bf16x8*)(Z + ((size_t)b * SEQ + (eb & 8191)) * INC + ZMQ + h * 64 + ks * 16 + hh * 8); }
            f32x16 A0, A1, B0, B1;
#pragma unroll
            for (int i = 0; i < 16; ++i) { A0[i] = 0.f; A1[i] = 0.f; B0[i] = 0.f; B1[i] = 0.f; }
            float mxa = -1e30f, la = 0.f, mxb = -1e30f, lb = 0.f;
            if (two) {
#pragma unroll 1
                for (int t = 0; t < 4; ++t) moba_tile2(lds, lds + MB_KBYTES, t, qa, qb, A0, A1, B0, B1, mxa, la, mxb, lb, ql, hh);
            } else {
#pragma unroll 1
                for (int t = 0; t < 4; ++t) moba_tile(lds, lds + MB_KBYTES, t, qa, A0, A1, mxa, la, false, 0, ql, hh);
            }
            la += __shfl_xor(la, 32); lb += __shfl_xor(lb, 32);
            if (va) moba_put_partial(PO, PM, ((size_t)bh * SEQ + (ea & 8191)) * 3 + (ea >> 13), A0, A1, mxa, la, hh);
            if (two && vb) moba_put_partial(PO, PM, ((size_t)bh * SEQ + (eb & 8191)) * 3 + (eb >> 13), B0, B1, mxb, lb, hh);
        }
    }
    __syncthreads();
}

__device__ __forceinline__ void moba_own_phase(const Args& a, LAS unsigned char* lds, int tid, int G, unsigned char* ws_, unsigned char* outb_) {
    unsigned char* ws = ws_; unsigned char* outb = outb_; (void)outb; const bf16* Z = (const bf16*)(ws + WS_HZ); bf16* Y = (bf16*)(ws + WS_Y); const bf16* VTM = (const bf16*)((const unsigned char*)outb + OUT_VTM);
    const bf16* PO = (const bf16*)((const unsigned char*)outb + OUT_PO); const float* PM = (const float*)((const unsigned char*)outb + OUT_PM);
    const int lane = tid & 63, w = tid >> 6, ql = lane & 31, hh = lane >> 5;
    const float C = 1.44269504089f;
    for (int e = blockIdx.x; e < BATCH * 4 * 32; e += G) {
        const int bh = e & 31, n = e >> 5, b = bh >> 2, h = bh & 3;
        const int sq = n * 256 + w * 32 + ql; const size_t rowq = (size_t)b * SEQ + sq;
        __syncthreads();
        int tl = tid; asm volatile("" : "+v"(tl));
        const bf16* Kg = Z + (size_t)b * SEQ * INC + ZMK + h * 64; const bf16* Vg = VTM + ((size_t)b * 256 + h * 64) * SEQ;
        MB_STAGE_LOAD(Kg, Vg, n);
        bf16x8 qf[4];
#pragma unroll
        for (int ks = 0; ks < 4; ++ks) qf[ks] = *(const bf16x8*)(Z + rowq * INC + ZMQ + h * 64 + ks * 16 + hh * 8);
        MB_STAGE_STORE();
        __syncthreads();
        f32x16 O0, O1;
#pragma unroll
        for (int i = 0; i < 16; ++i) { O0[i] = 0.f; O1[i] = 0.f; }
        float mx = -1e30f, l = 0.f;
        const int qpos = w * 32 + ql, nt = (w >> 1) + 1;
#pragma unroll 1
        for (int t = 0; t < nt; ++t) moba_tile(lds, lds + MB_KBYTES, t, qf, O0, O1, mx, l, t == nt - 1, qpos, ql, hh);
        l += __shfl_xor(l, 32);
        const int nsel = n < 3 ? n : 3;
        const size_t pbase = ((size_t)bh * SEQ + sq) * 3;
        float mt[3], lt[3], M = mx;
#pragma unroll
        for (int t = 0; t < 3; ++t) { mt[t] = -1e30f; lt[t] = 0.f; if (t < nsel) { mt[t] = PM[(pbase + t) * 2]; lt[t] = PM[(pbase + t) * 2 + 1]; M = fmaxf(M, mt[t]); } }
        const float wo = __builtin_amdgcn_exp2f((mx - M) * C);
        float Lsum = l * wo;
#pragma unroll
        for (int i = 0; i < 16; ++i) { O0[i] *= wo; O1[i] *= wo; }
#pragma unroll
        for (int t = 0; t < 3; ++t) if (t < nsel) {
            const float wt = __builtin_amdgcn_exp2f((mt[t] - M) * C) * lt[t]; Lsum += wt;
            const bf16* po = PO + (pbase + t) * 64 + 4 * hh;
#pragma unroll
            for (int i4 = 0; i4 < 4; ++i4) { const u32x2 p0 = *(const u32x2*)(po + 8 * i4), p1 = *(const u32x2*)(po + 32 + 8 * i4);
                O0[4 * i4] += wt * bflo(p0.x); O0[4 * i4 + 1] += wt * bfhi(p0.x); O0[4 * i4 + 2] += wt * bflo(p0.y); O0[4 * i4 + 3] += wt * bfhi(p0.y);
                O1[4 * i4] += wt * bflo(p1.x); O1[4 * i4 + 1] += wt * bfhi(p1.x); O1[4 * i4 + 2] += wt * bflo(p1.y); O1[4 * i4 + 3] += wt * bfhi(p1.y); }
        }
        const float inv = 1.0f / Lsum;
        bf16* yp = Y + rowq * D + 768 + h * 64 + 4 * hh;
#pragma unroll
        for (int i4 = 0; i4 < 4; ++i4) {
            u32x2 o0, o1;
            o0.x = pk2(O0[4 * i4] * inv, O0[4 * i4 + 1] * inv); o0.y = pk2(O0[4 * i4 + 2] * inv, O0[4 * i4 + 3] * inv);
            o1.x = pk2(O1[4 * i4] * inv, O1[4 * i4 + 1] * inv); o1.y = pk2(O1[4 * i4 + 2] * inv, O1[4 * i4 + 3] * inv);
            *(u32x2*)(yp + 8 * i4) = o0; *(u32x2*)(yp + 32 + 8 * i4) = o1;
        }
    }
    __syncthreads();
}

__device__ __forceinline__ void ret_kv_phase(const Args& a, int tid, int G, unsigned char* ws_, unsigned char* outb_) {
    unsigned char* ws = ws_; unsigned char* outb = outb_; (void)outb; const bf16* VTR = (const bf16*)((const unsigned char*)outb + OUT_VTR); const bf16* KTZ = (const bf16*)((const unsigned char*)outb + OUT_KTZ); float* KV = (float*)(ws + WS_KV);
    const int lane = tid & 63, w = tid >> 6, ql = lane & 31, hh = lane >> 5, eb = w >> 1, db = w & 1;
    for (int it = blockIdx.x; it < BATCH * 4 * 32; it += G) {
        const int j = it & 31, h = (it >> 5) & 3, b = it >> 7;
        const bf16* ap = VTR + ((size_t)b * 512 + h * 128 + eb * 32 + ql) * SEQ + j * 256 + 8 * hh;
        const bf16* bp = KTZ + ((size_t)b * 256 + h * 64 + db * 32 + ql) * SEQ + j * 256 + 8 * hh;
        f32x16 acc;
#pragma unroll
        for (int i = 0; i < 16; ++i) acc[i] = 0.f;
#pragma unroll
        for (int half = 0; half < 2; ++half) {
            bf16x8 av[8], bv[8];
#pragma unroll
            for (int s = 0; s < 8; ++s) { av[s] = *(const bf16x8*)(ap + (half * 8 + s) * 16); bv[s] = *(const bf16x8*)(bp + (half * 8 + s) * 16); }
#pragma unroll
            for (int s = 0; s < 8; ++s) acc = MFMA32(av[s], bv[s], acc);
        }
        float* o = KV + (size_t)it * 8192 + (size_t)(eb * 32) * 64 + db * 32 + ql;
#pragma unroll
        for (int i = 0; i < 16; ++i) o[crow(i, hh) * 64] = acc[i];
    }
}
__device__ __forceinline__ void ret_scan_phase(const Args& a, int tid, int G, unsigned char* ws_, unsigned char* outb_) {
    unsigned char* ws = ws_; unsigned char* outb = outb_; (void)outb; const float* KV = (const float*)(ws + WS_KV); bf16* RSb = (bf16*)(ws + WS_RS);
    for (int i = blockIdx.x * NTHR + tid; i < 32 * 4096; i += G * NTHR) {
        const int bh = i >> 12, el = (i & 4095) * 2; const float gC = __builtin_amdgcn_exp2f(a.lg2g[bh & 3] * 256.0f);
        float S0 = 0.f, S1 = 0.f;
        for (int j = 0; j < 32; ++j) { const size_t o = ((size_t)bh * 32 + j) * 8192 + el; *(unsigned*)(RSb + o) = pk2(S0, S1); const float k0 = KV[o], k1 = KV[o + 1]; S0 = gC * S0 + k0; S1 = gC * S1 + k1; }
    }
}
constexpr int RT_KROW = 144, RT_VROW = 528, RT_KBYTES = 256 * RT_KROW;
static_assert(RT_KBYTES + 128 * RT_VROW <= LDS_BYTES, "ret lds");
__device__ __forceinline__ void ret_out_phase(const Args& a, LAS unsigned char* lds, int tid, int G, unsigned char* ws_, unsigned char* outb_) {
    unsigned char* ws = ws_; unsigned char* outb = outb_; (void)outb;
    const bf16* Z = (const bf16*)(ws + WS_HZ); bf16* Y = (bf16*)(ws + WS_Y); const bf16* VTR = (const bf16*)((const unsigned char*)outb + OUT_VTR); const bf16* RSb = (const bf16*)(ws + WS_RS);
    const int lane = tid & 63, w = tid >> 6, ql = lane & 31, hh = lane >> 5;
    for (int it = blockIdx.x; it < BATCH * 4 * 32; it += G) {
        const int j = it & 31, h = (it >> 5) & 3, b = it >> 7;
        const size_t rowc = (size_t)b * SEQ + j * 256, rowq = rowc + w * 32 + ql;
        const float lg = a.lg2g[h];
        __syncthreads();
        int tl = tid; asm volatile("" : "+v"(tl));
        u32x4 stk[4], stv[8];
#pragma unroll
        for (int c = 0; c < 4; ++c) { const int ch = tl + NTHR * c; stk[c] = *(const u32x4*)(Z + (rowc + (ch >> 3)) * INC + ZK + h * 64 + (ch & 7) * 8); }
#pragma unroll
        for (int c = 0; c < 8; ++c) { const int ch = tl + NTHR * c; stv[c] = *(const u32x4*)(VTR + ((size_t)b * 512 + h * 128 + (ch >> 5)) * SEQ + j * 256 + (ch & 31) * 8); }
        bf16x8 qf[4];
#pragma unroll
        for (int ks = 0; ks < 4; ++ks) qf[ks] = *(const bf16x8*)(Z + rowq * INC + ZQ + h * 64 + ks * 16 + hh * 8);
        f32x16 O[4];
#pragma unroll
        for (int eb = 0; eb < 4; ++eb) {
#pragma unroll
            for (int i = 0; i < 16; ++i) O[eb][i] = 0.f;
            const bf16* rp = RSb + (size_t)it * 8192 + (size_t)(eb * 32 + ql) * 64 + 8 * hh;
#pragma unroll
            for (int ks = 0; ks < 4; ++ks) { const bf16x8 ra = *(const bf16x8*)(rp + ks * 16); O[eb] = MFMA32(ra, qf[ks], O[eb]); }
            __builtin_amdgcn_sched_barrier(0);
        }
        const int qpos = w * 32 + ql;
        { const float xi = __builtin_amdgcn_exp2f(lg * (float)(qpos + 1));
#pragma unroll
          for (int eb = 0; eb < 4; ++eb)
#pragma unroll
              for (int i = 0; i < 16; ++i) O[eb][i] *= xi; }
#pragma unroll
        for (int c = 0; c < 4; ++c) { const int ch = tl + NTHR * c; *(LAS u32x4*)(lds + (ch >> 3) * RT_KROW + (ch & 7) * 16) = stk[c]; }
#pragma unroll
        for (int c = 0; c < 8; ++c) { const int ch = tl + NTHR * c; *(LAS u32x4*)(lds + RT_KBYTES + (ch >> 5) * RT_VROW + (ch & 31) * 16) = stv[c]; }
        __syncthreads();
        for (int kb = 0; kb <= w; ++kb) {
            f32x16 s;
#pragma unroll
            for (int i = 0; i < 16; ++i) s[i] = 0.f;
#pragma unroll
            for (int ks = 0; ks < 4; ++ks) { const bf16x8 ka = *(const LAS bf16x8*)(lds + (32 * kb + ql) * RT_KROW + (16 * ks + 8 * hh) * 2); s = MFMA32(ka, qf[ks], s); }
#pragma unroll
            for (int i = 0; i < 16; ++i) { const int diff = qpos - 32 * kb - crow(i, hh); const float fdec = __builtin_amdgcn_exp2f(lg * (float)diff); s[i] = diff >= 0 ? s[i] * fdec : 0.f; }
#pragma unroll
            for (int s2 = 0; s2 < 2; ++s2) {
                union { u32x4 u; bf16x8 v; } pb;
                pb.u.x = pk2(s[8 * s2], s[8 * s2 + 1]); pb.u.y = pk2(s[8 * s2 + 2], s[8 * s2 + 3]); pb.u.z = pk2(s[8 * s2 + 4], s[8 * s2 + 5]); pb.u.w = pk2(s[8 * s2 + 6], s[8 * s2 + 7]);
                const int kp = 32 * kb + 16 * s2 + 8 * hh;
#pragma unroll
                for (int eb = 0; eb < 4; ++eb) { const bf16x8 va = *(const LAS bf16x8*)(lds + RT_KBYTES + (eb * 32 + ql) * RT_VROW + kp * 2); O[eb] = MFMA32(va, pb.v, O[eb]); }
            }
        }
        float s1 = 0.f;
#pragma unroll
        for (int eb = 0; eb < 4; ++eb)
#pragma unroll
            for (int i = 0; i < 16; ++i) s1 += O[eb][i];
        s1 += __shfl_xor(s1, 32);
        const float mean = s1 * (1.0f / 128.0f); float s2 = 0.f;
#pragma unroll
        for (int eb = 0; eb < 4; ++eb)
#pragma unroll
            for (int i = 0; i < 16; ++i) { O[eb][i] -= mean; s2 += O[eb][i] * O[eb][i]; }
        s2 += __shfl_xor(s2, 32);
        const float rstd = 1.0f / sqrtf(s2 * (1.0f / 128.0f) + 1e-6f);
        const bf16* gp = Z + rowq * INC + ZG + h * 128 + 4 * hh; bf16* yp = Y + rowq * D + h * 128 + 4 * hh;
#pragma unroll
        for (int eb = 0; eb < 4; ++eb)
#pragma unroll
            for (int i4 = 0; i4 < 4; ++i4) {
                const u32x2 gw = *(const u32x2*)(gp + eb * 32 + 8 * i4);
                const float r0 = O[eb][4 * i4] * rstd * pg8::silu_f(bflo(gw.x)), r1 = O[eb][4 * i4 + 1] * rstd * pg8::silu_f(bfhi(gw.x)),
                            r2 = O[eb][4 * i4 + 2] * rstd * pg8::silu_f(bflo(gw.y)), r3 = O[eb][4 * i4 + 3] * rstd * pg8::silu_f(bfhi(gw.y));
                u32x2 o; o.x = pk2(r0, r1); o.y = pk2(r2, r3); *(u32x2*)(yp + eb * 32 + 8 * i4) = o;
            }
    }
    __syncthreads();
}

__device__ __forceinline__ void phase_m1(const Args& a, int L, LAS unsigned char* lds, int tid, int G, unsigned char* ws_, unsigned char* outb_) {
    unsigned char* ws = ws_; unsigned char* outb = outb_; (void)outb;
    const bf16* Z = (const bf16*)(ws + WS_HZ); bf16* Y = (bf16*)(ws + WS_Y);
    const int lane = tid & 63, w = tid >> 6, ql = lane & 31, hh = lane >> 5, g = w >> 1, db = w & 1;
    LAS bf16* U = (LAS bf16*)lds;
    LAS bf16* Pb = (LAS bf16*)(lds + 24576);
    const float* pw = a.in[8] + (size_t)L * 4 * 64 * 64; const float scl = a.in[9][L * 256 + g * 64 + db * 32 + ql];
    bf16x8 wb[4];
#pragma unroll
    for (int ks = 0; ks < 4; ++ks) { float v[8];
#pragma unroll
        for (int j = 0; j < 8; ++j) v[j] = pw[(size_t)(g * 64 + ks * 16 + hh * 8 + j) * 64 + db * 32 + ql];
        union { u32x4 u; bf16x8 b; } t; t.u.x = pk2(v[0], v[1]); t.u.y = pk2(v[2], v[3]); t.u.z = pk2(v[4], v[5]); t.u.w = pk2(v[6], v[7]); wb[ks] = t.b; }
    for (int tile = blockIdx.x; tile < M / 32; tile += G) {
        const int r0 = tile * 32, sp0 = r0 & (SEQ - 1);
        __syncthreads();
        for (int c = tid; c < 47 * 32; c += NTHR) { const int i = c >> 5, cc = c & 31;
            if (sp0 + i - 15 >= 0) *(LAS u32x4*)(U + i * 256 + cc * 8) = *(const u32x4*)(Z + (size_t)(r0 + i - 15) * INC + ZP + cc * 8); }
        __syncthreads();
#pragma unroll 4
        for (int k = 0; k < 16; ++k) {
            const int idx = tid + NTHR * k, t = idx >> 8, ch = idx & 255, win = 2 << (ch >> 6);
            const int sp = sp0 + t; const int nb = (sp + 1 < win) ? (sp + 1) : win;
            const LAS bf16* up = U + (15 + t) * 256 + ch;
            float s = 0.f;
#pragma unroll
            for (int ww = 0; ww < 16; ++ww) if (ww < nb) s += bf1(up[-ww * 256]);
            Pb[t * 264 + ch] = (bf16)f2bf(s / (float)nb - bf1(up[0]));
        }
        __syncthreads();
        f32x16 acc;
#pragma unroll
        for (int i = 0; i < 16; ++i) acc[i] = 0.f;
#pragma unroll
        for (int ks = 0; ks < 4; ++ks) { const bf16x8 pa = *(const LAS bf16x8*)(Pb + ql * 264 + g * 64 + ks * 16 + hh * 8); acc = MFMA32(pa, wb[ks], acc); }
        bf16* yp = Y + (size_t)r0 * D + 512 + g * 64 + db * 32 + ql;
#pragma unroll
        for (int i = 0; i < 16; ++i) yp[(size_t)crow(i, hh) * D] = (bf16)f2bf(acc[i] * scl);
    }
    __syncthreads();
}

__device__ __forceinline__ void phase_final(const Args& a, int lane, int wave, int G) {
    const float* g = a.in[18]; float* xo = a.out; const bf16* xb = (const bf16*)(a.ws + WS_XB2);
    const int gw = blockIdx.x * NWAVES + wave, NGW = G * NWAVES;
    const f32x4* gp = (const f32x4*)g + lane;
    for (int m = gw; m < M; m += NGW) {
        const u32x2* br = (const u32x2*)(xb + (size_t)m * D) + lane; f32x4* xr = (f32x4*)(xo + (size_t)m * D) + lane; f32x4 v[4]; float s = 0.f;
#pragma unroll
        for (int j = 0; j < 4; ++j) { const u32x2 w = br[64 * j]; v[j][0] = bflo(w.x); v[j][1] = bfhi(w.x); v[j][2] = bflo(w.y); v[j][3] = bfhi(w.y); s += (v[j][0] * v[j][0] + v[j][1] * v[j][1]) + (v[j][2] * v[j][2] + v[j][3] * v[j][3]); }
        const float r = 1.0f / sqrtf(wave_sum(s) * (1.0f / D) + 1e-6f);
#pragma unroll
        for (int j = 0; j < 4; ++j) xr[64 * j] = v[j] * r * gp[64 * j];
    }
}

#define RLX_AGENT __ATOMIC_RELAXED, __HIP_MEMORY_SCOPE_AGENT
#define XB_TMO      128
#define XB_XCNT(j)  (256  + 64 * (j))
#define XB_XSUB(j)  (1280 + 64 * (j))
#define XB_XGEN(j)  (2304 + 64 * (j))
#define XB_TOP      3328
#define XB_TOPGEN   3392
#define XCD_BAR_WORDS 3456
#define XB_SPIN_CAP (1u << 18)

__device__ __forceinline__ unsigned xb_ld(unsigned* p)              { return __hip_atomic_load(p, __ATOMIC_RELAXED, __HIP_MEMORY_SCOPE_AGENT); }
__device__ __forceinline__ unsigned xb_add(unsigned* p, unsigned v) { return __hip_atomic_fetch_add(p, v, __ATOMIC_RELAXED, __HIP_MEMORY_SCOPE_AGENT); }
__device__ __forceinline__ unsigned xb_xcc_id() { return (unsigned)__builtin_amdgcn_s_getreg((3 << 11) | 20) & 0xFu; }
#define XB_SPIN(cond, bar) do { unsigned _sp = 0; while (cond) { __builtin_amdgcn_s_sleep(1); \
    if ((++_sp & 255u) == 0u) { if (xb_ld(&(bar)[XB_TMO])) break; if (_sp > XB_SPIN_CAP) { atomicAdd(&(bar)[XB_TMO], 1u); break; } } } } while (0)

struct XcdBarrier {
    unsigned* bar; unsigned x;
    volatile LAS unsigned* st;
};

__device__ __forceinline__ XcdBarrier xcd_barrier_post(unsigned* bar, volatile LAS unsigned* st) {
    XcdBarrier b; b.bar = bar; b.x = xb_xcc_id(); b.st = st;
    if (threadIdx.x == 0) (void)xb_add(&bar[XB_XCNT(b.x)], 1u);
    return b;
}
__device__ __forceinline__ void xcd_barrier_complete(unsigned* bar, unsigned x, unsigned& nloc, unsigned& nx) {
    const unsigned G = gridDim.x * gridDim.y * gridDim.z;
    unsigned sum, cnt, mine, sp = 0u;
    for (;;) {
        sum = 0u; cnt = 0u; mine = 0u;
#pragma unroll
        for (unsigned j = 0; j < 16; ++j) { const unsigned c = xb_ld(&bar[XB_XCNT(j)]); sum += c; cnt += (c > 0u) ? 1u : 0u; mine = (j == x) ? c : mine; }
        if (sum == G) break;
        __builtin_amdgcn_s_sleep(1);
        if ((++sp & 255u) == 0u) { if (xb_ld(&bar[XB_TMO])) break; if (sp > XB_SPIN_CAP) { atomicAdd(&bar[XB_TMO], 1u); break; } }
    }
    nloc = mine > 0u ? mine : 1u; nx = cnt > 0u ? cnt : 1u;
}

__device__ __noinline__ void xcd_barrier_fn(unsigned* bar_, volatile LAS unsigned* st_) {
    XcdBarrier b; b.bar = bar_; b.x = xb_xcc_id(); b.st = st_;
    asm volatile("s_waitcnt vmcnt(0)" ::: "memory");
    __syncthreads();
    if (threadIdx.x == 0) {
        unsigned* bar = b.bar;
        __builtin_amdgcn_s_waitcnt(0);
        unsigned nloc = b.st[0], nx = b.st[1];
        if (nloc == 0u) { xcd_barrier_complete(bar, b.x, nloc, nx); b.st[0] = nloc; b.st[1] = nx; }
        const unsigned old = xb_add(&bar[XB_XSUB(b.x)], 1u);
        const unsigned gen = old / nloc;
        if (old + 1u == (gen + 1u) * nloc) {
            __builtin_amdgcn_fence(__ATOMIC_RELEASE, "agent");
            asm volatile("s_waitcnt vmcnt(0)" ::: "memory");
            const unsigned og = xb_add(&bar[XB_TOP], 1u);
            const unsigned tg = og / nx;
            if (og + 1u == (tg + 1u) * nx) xb_add(&bar[XB_TOPGEN], 1u);
            else XB_SPIN(xb_ld(&bar[XB_TOPGEN]) == tg, bar);
            __builtin_amdgcn_fence(__ATOMIC_ACQUIRE, "agent");
            xb_add(&bar[XB_XGEN(b.x)], 1u);
            asm volatile("s_waitcnt vmcnt(0)" ::: "memory");
        } else {
            XB_SPIN(xb_ld(&bar[XB_XGEN(b.x)]) == gen, bar);
            __builtin_amdgcn_fence(__ATOMIC_ACQUIRE, "agent");
            asm volatile("s_waitcnt vmcnt(0)" ::: "memory");
        }
    }
    __syncthreads();
}

constexpr int N_PHASES = 2 + 11 * DEPTH;
__global__ void __launch_bounds__(NTHR, 2) mega_fwd(Args a) {
    extern __shared__ __attribute__((aligned(16))) unsigned char lds_raw[];
    LAS unsigned char* lds = (LAS unsigned char*)lds_raw;
    cg::grid_group grid = cg::this_grid();
    int tid = threadIdx.x, lane = tid & 63, G = gridDim.x; const int wave = __builtin_amdgcn_readfirstlane(tid >> 6);
    unsigned char* ws = a.ws; unsigned char* outb = (unsigned char*)a.out;
    bf16* XB = (bf16*)(ws + WS_XB); bf16* HZ = (bf16*)(ws + WS_HZ); bf16* Y = (bf16*)(ws + WS_Y);
    float* SS0 = (float*)(ws + WS_SS0); float* SS1 = (float*)(ws + WS_SS1); const float* CS = (const float*)(ws + WS_CS);
    const int lo = a.ph_lo, hi = a.ph_hi;
    volatile LAS unsigned* bst = (volatile LAS unsigned*)(lds + LDS_BYTES - 64);
    if (tid < 2) bst[tid] = 0u;
    if (blockIdx.x == 0) for (int i = tid; i < 4096; i += NTHR) __hip_atomic_store((unsigned*)a.ws + i, 0u, RLX_AGENT);
    __syncthreads();
#define FRESH() do { asm volatile("" : "+s"(ws)); asm volatile("" : "+s"(outb)); asm volatile("" : "+s"(G)); asm volatile("" : "+v"(tid)); lane = tid & 63; XB = (bf16*)(ws + WS_XB); HZ = (bf16*)(ws + WS_HZ); Y = (bf16*)(ws + WS_Y); SS0 = (float*)(ws + WS_SS0); SS1 = (float*)(ws + WS_SS1); CS = (const float*)(ws + WS_CS); } while (0)
#ifndef PH_MASK
#define PH_MASK 0x1FFFu
#endif
#define EN(j) ((PH_MASK >> (j)) & 1u)
#ifndef REP_MASK
#define REP_MASK 0u
#endif
#define NREP(j) (1 + (int)((REP_MASK >> (j)) & 1u))
#define IN(k) (lo <= (k) && (k) < hi)
#define SEAM(k) do { if (IN(k) && IN((k) + 1)) xcd_barrier_fn((unsigned*)a.ws, (volatile LAS unsigned*)(lds + LDS_BYTES - 64)); } while (0)
    if (EN(11) && IN(0)) { _Pragma("unroll 1") for (int rep = 0; rep < NREP(11); ++rep) { phase_prologue(a, lds, tid, lane, wave, G); } } if (IN(0) && IN(1)) { grid.sync(); } (void)xcd_barrier_post((unsigned*)a.ws, bst);
#pragma unroll 1
    for (int L = 0; L < DEPTH; ++L) {
        const int pb = 1 + 11 * L;
#define WL() const bf16* wl = (const bf16*)(ws + WS_W) + (size_t)L * W_LAYER
        if (EN(0) && IN(pb + 0)) { FRESH(); WL(); pg8::Gemm g{(const bf16*)(ws + WS_XB2), wl + W_GU1, M, 2 * FF, D}; pg8::StaticOrder S; S.init(M, 2 * FF, G, (int)blockIdx.x); pg8::EpiGLU E{HZ, FF, SS0};
            _Pragma("unroll 1") for (int rep = 0; rep < NREP(0); ++rep) { pg8::gemm_phase<pg8::EpiGLU, pg8::StaticOrder, true, true>(lds, g, S, E); } } SEAM(pb + 0);
        if (EN(1) && IN(pb + 1)) { FRESH(); WL(); pg8::Gemm g{HZ, wl + W_D1, M, D, FF}; pg8::StaticOrder S; S.init(M, D, G, (int)blockIdx.x); pg8::EpiRes<0> E{(const bf16*)(ws + WS_XB2), XB, SS1, 0.5f, nullptr, nullptr};
            pg8::gemm_phase<pg8::EpiRes<0>, pg8::StaticOrder, true, true>(lds, g, S, E); } SEAM(pb + 1);
        if (EN(2) && IN(pb + 2)) { FRESH(); WL(); pg8::Gemm g{XB, wl + W_IN, M, INC, D}; pg8::StaticOrder S; S.init(M, INC, G, (int)blockIdx.x); pg8::EpiZ E{HZ, SS1, CS};
            _Pragma("unroll 1") for (int rep = 0; rep < NREP(2); ++rep) { pg8::gemm_phase<pg8::EpiZ, pg8::StaticOrder, true, true>(lds, g, S, E); } } SEAM(pb + 2);
        if (EN(3) && IN(pb + 3)) { FRESH(); _Pragma("unroll 1") for (int rep = 0; rep < NREP(3); ++rep) { phase_m1(a, L, lds, tid, G, ws, outb); prep_transposes(a, lds, tid, G, ws, outb); } } SEAM(pb + 3);
        if (EN(4) && IN(pb + 4)) { FRESH(); _Pragma("unroll 1") for (int rep = 0; rep < NREP(4); ++rep) { ret_kv_phase(a, tid, G, ws, outb); moba_gate_phase(a, lds, tid, G, ws, outb); } } SEAM(pb + 4);
        if (EN(5) && IN(pb + 5)) { FRESH(); _Pragma("unroll 1") for (int rep = 0; rep < NREP(5); ++rep) { ret_scan_phase(a, tid, G, ws, outb); moba_past_phase(a, L, lds, tid, G, ws, outb); } } SEAM(pb + 5);
        if (EN(6) && IN(pb + 6)) { FRESH(); _Pragma("unroll 1") for (int rep = 0; rep < NREP(6); ++rep) { ret_out_phase(a, lds, tid, G, ws, outb); moba_own_phase(a, lds, tid, G, ws, outb); } } SEAM(pb + 6);
        if (EN(7) && IN(pb + 7)) { FRESH(); WL(); pg8::Gemm g{Y, wl + W_OUT, M, D, D}; pg8::StaticOrder S; S.init(M, D, G, (int)blockIdx.x); pg8::EpiRes<0> E{XB, XB, SS0, 1.0f, nullptr, nullptr};
            pg8::gemm_phase<pg8::EpiRes<0>, pg8::StaticOrder, true, true>(lds, g, S, E); } SEAM(pb + 7);
        if (EN(8) && IN(pb + 8)) { FRESH(); WL(); pg8::Gemm g{XB, wl + W_GU2, M, 2 * FF, D}; pg8::StaticOrder S; S.init(M, 2 * FF, G, (int)blockIdx.x); pg8::EpiGLU E{HZ, FF, SS0};
            _Pragma("unroll 1") for (int rep = 0; rep < NREP(0); ++rep) { pg8::gemm_phase<pg8::EpiGLU, pg8::StaticOrder, true, true>(lds, g, S, E); } }
        if (EN(8) && IN(pb + 8)) { FRESH(); WL(); pg8::Gemm g{(const bf16*)(ws + WS_PB) + (size_t)L * M * PLE, wl + W_PP, M, D, PLE}; pg8::StaticOrder S; S.init(M, D, G, (int)blockIdx.x); pg8::EpiPlain E{Y, D};
            _Pragma("unroll 1") for (int rep = 0; rep < NREP(8); ++rep) { pg8::gemm_phase<pg8::EpiPlain, pg8::StaticOrder, true, true>(lds, g, S, E); } } SEAM(pb + 8);
        if (EN(9) && IN(pb + 9)) { FRESH(); WL(); pg8::Gemm g{HZ, wl + W_D2, M, D, FF}; pg8::StaticOrder S; S.init(M, D, G, (int)blockIdx.x); pg8::EpiRes<0> E{XB, XB, SS1, 0.5f, nullptr, nullptr};
            pg8::gemm_phase<pg8::EpiRes<0>, pg8::StaticOrder, true, true>(lds, g, S, E); } SEAM(pb + 9);
        if (EN(10) && IN(pb + 10)) { FRESH(); WL(); pg8::Gemm g{XB, wl + W_PG, M, D, D}; pg8::StaticOrder S; S.init(M, D, G, (int)blockIdx.x); pg8::EpiRes<1> E{XB, (bf16*)(ws + WS_XB2), SS0, 1.0f, SS1, Y};
            pg8::gemm_phase<pg8::EpiRes<1>, pg8::StaticOrder, true, true>(lds, g, S, E); } SEAM(pb + 10);
    }
    if (EN(12) && IN(N_PHASES - 1)) phase_final(a, lane, wave, G);
#undef IN
#undef SEAM
}

extern "C" void kernel_launch(void* const* d_in, const int* in_sizes, int n_in, void* d_out, int out_size, void* d_ws, size_t ws_size, hipStream_t stream) {
    static int grid = 0;
    if (grid == 0) {
        if (n_in != 19 || out_size != M * D || ws_size < WS_END) { fprintf(stderr, "kernel_launch: unexpected shapes: n_in %d out %d ws %zu (need %zu)\n", n_in, out_size, ws_size, (size_t)WS_END); grid = -1; return; }
        int dev = 0, cus = 0, per_cu = 0;
        if (hipGetDevice(&dev) != hipSuccess || hipDeviceGetAttribute(&cus, hipDeviceAttributeMultiprocessorCount, dev) != hipSuccess) { grid = -1; return; }
        if (hipFuncSetAttribute((const void*)mega_fwd, hipFuncAttributeMaxDynamicSharedMemorySize, LDS_BYTES) != hipSuccess) { fprintf(stderr, "kernel_launch: hipFuncSetAttribute failed\n"); grid = -1; return; }
        if (hipOccupancyMaxActiveBlocksPerMultiprocessor(&per_cu, (const void*)mega_fwd, NTHR, LDS_BYTES) != hipSuccess || per_cu < 1) { fprintf(stderr, "kernel_launch: occupancy query says %d\n", per_cu); per_cu = 1; }
        (void)hipGetLastError();
        grid = cus;
    }
    if (grid < 0) return;
    Args a{};
    for (int i = 0; i < 19; ++i) a.in[i] = (const float*)d_in[i];
    a.out = (float*)d_out; a.ws = (unsigned char*)d_ws;
    for (int i = 0; i < 32; ++i) a.theta[i] = 1.0 / pow(10000.0, (double)i / 31.0);
    for (int h = 0; h < 4; ++h) a.lg2g[h] = (float)log2(1.0 - pow(2.0, -5.0 - (double)h));
    a.ph_lo = 0; a.ph_hi = N_PHASES;
    void* args[] = {&a};
    hipError_t e = hipLaunchCooperativeKernel((const void*)mega_fwd, dim3(grid), dim3(NTHR), args, LDS_BYTES, stream);
    if (e != hipSuccess) fprintf(stderr, "kernel_launch: cooperative launch failed: %s (grid %d)\n", hipGetErrorString(e), grid);
}
```
